# Optimizing an MI355X kernel written in HIP

```python
import math
import jax, jax.numpy as jnp
from jax import lax
import numpy as np

D_MODEL = 1024
BATCH = 16
SEQ = 2048
DEPTH = 1

N_MEM = 256
DA_HEADS = 4
DA_HEAD_DIM = 64
DA_V_DIM = 2 * DA_HEAD_DIM
DA_WIDTH = DA_HEADS * 2 * DA_HEAD_DIM
ROPE_THETA = 10000.0
Q_BLOCK = 128
SSM_WIDTH = 512
SSM_GROUP = 16
SSM_GROUPS = SSM_WIDTH // SSM_GROUP
SSM_STATE = 64
X_HEADS = 4
X_HEAD_DIM = D_MODEL // X_HEADS
N_EXPERTS = 32
TOP_K = 4
D_FF = D_MODEL
SWIGLU_LIMIT = 7.0
SWIGLU_ALPHA = 1.702
MOE_BLOCK = 256
EPS = 1e-6
IN_WIDTH = 3 * DA_WIDTH + SSM_WIDTH + 2 * D_MODEL
IN_SPLITS = (DA_WIDTH, 2 * DA_WIDTH, 3 * DA_WIDTH, 3 * DA_WIDTH + SSM_WIDTH, 3 * DA_WIDTH + SSM_WIDTH + D_MODEL)

kernel_name = 'hybrid_diffattn_s5_moe_encoder_layer'


def rms_norm(x, g):
    xf = x.astype(jnp.float32)
    y = xf * lax.rsqrt(jnp.mean(xf * xf, axis=-1, keepdims=True) + EPS)
    return (y * g.astype(jnp.float32)).astype(x.dtype)


def rope(x, pos):
    dh = x.shape[-1]
    half = dh // 2
    inv = ROPE_THETA ** (-jnp.arange(half, dtype=jnp.float32) * (2.0 / dh))
    ang = pos.astype(jnp.float32)[:, None] * inv[None, :]
    shape = (1, pos.shape[0]) + (1,) * (x.ndim - 3) + (half,)
    cos = jnp.cos(ang).reshape(shape)
    sin = jnp.sin(ang).reshape(shape)
    xf = x.astype(jnp.float32)
    x1, x2 = xf[..., :half], xf[..., half:]
    return jnp.concatenate([x1 * cos - x2 * sin, x2 * cos + x1 * sin], axis=-1).astype(x.dtype)


def diff_attention(q, k, v, lam, subln_g, lambda_init):
    b, l = q.shape[:2]
    nb = l // Q_BLOCK
    scale = DA_HEAD_DIM ** -0.5
    qb = q.reshape(b, nb, Q_BLOCK, DA_HEADS, 2, DA_HEAD_DIM).swapaxes(0, 1)

    def one_block(qi):
        s = jnp.einsum('bqhcd,bkhcd->bhcqk', qi, k, preferred_element_type=jnp.float32) * scale
        p = jax.nn.softmax(s, axis=-1)
        w = p[:, :, 0] - lam * p[:, :, 1]
        return jnp.einsum('bhqk,bkhe->bqhe', w.astype(v.dtype), v)

    o = lax.map(one_block, qb)
    o = o.swapaxes(0, 1).reshape(b, l, DA_HEADS, DA_V_DIM)
    o = rms_norm(o, subln_g) * (1.0 - lambda_init)
    return o.reshape(b, l, DA_WIDTH)


def s5_direction(u, a_re, a_im, log_dt, b_re, b_im, c_re, c_im, reverse):
    f32 = jnp.float32
    a_re = a_re.astype(f32)
    a_im = a_im.astype(f32)
    dt = jnp.exp(log_dt.astype(f32))[:, None]
    mag = jnp.exp(a_re * dt)
    ang = a_im * dt
    ab_re = mag * jnp.cos(ang)
    ab_im = mag * jnp.sin(ang)
    den = a_re * a_re + a_im * a_im
    nr = ab_re - 1.0
    coef_re = (nr * a_re + ab_im * a_im) / den
    coef_im = (ab_im * a_re - nr * a_im) / den
    b_re = b_re.astype(f32)
    b_im = b_im.astype(f32)
    bb_re = coef_re[..., None] * b_re - coef_im[..., None] * b_im
    bb_im = coef_re[..., None] * b_im + coef_im[..., None] * b_re
    bu_re = jnp.einsum('lbgh,gph->lbgp', u, bb_re)
    bu_im = jnp.einsum('lbgh,gph->lbgp', u, bb_im)
    l = u.shape[0]
    sa_re = jnp.broadcast_to(ab_re[None, None], (l, 1) + ab_re.shape)
    sa_im = jnp.broadcast_to(ab_im[None, None], (l, 1) + ab_im.shape)

    def combine(e1, e2):
        a1r, a1i, b1r, b1i = e1
        a2r, a2i, b2r, b2i = e2
        return (a2r * a1r - a2i * a1i,
                a2r * a1i + a2i * a1r,
                a2r * b1r - a2i * b1i + b2r,
                a2r * b1i + a2i * b1r + b2i)

    _, _, xr, xi = lax.associative_scan(combine, (sa_re, sa_im, bu_re, bu_im), reverse=reverse, axis=0)
    return (jnp.einsum('lbgp,ghp->lbgh', xr, c_re.astype(f32))
            - jnp.einsum('lbgp,ghp->lbgh', xi, c_im.astype(f32)))


def s5_mixer(u, a_re, a_im, log_dt, b_re, b_im, c_re, c_im, d_skip, w_glu):
    b, l, _ = u.shape
    uf = u.astype(jnp.float32)
    ug = uf.reshape(b, l, SSM_GROUPS, SSM_GROUP).transpose(1, 0, 2, 3)
    y = (s5_direction(ug, a_re[0], a_im[0], log_dt[0], b_re[0], b_im[0], c_re[0], c_im[0], False)
         + s5_direction(ug, a_re[1], a_im[1], log_dt[1], b_re[1], b_im[1], c_re[1], c_im[1], True))
    y = y.transpose(1, 0, 2, 3).reshape(b, l, SSM_WIDTH) + d_skip.astype(jnp.float32) * uf
    y = jax.nn.gelu(y).astype(u.dtype)
    val, gate = jnp.split(y @ w_glu, 2, axis=-1)
    return val * jax.nn.sigmoid(gate)


def hybrid_mixer(hn, w_in, lambda_q1, lambda_k1, lambda_q2, lambda_k2, subln_g,
                 a_re, a_im, log_dt, b_re, b_im, c_re, c_im, d_skip, w_glu,
                 w_branch_attn, w_branch_ssm, w_mix_out, lambda_init):
    b, l, _ = hn.shape
    q, k, v, u, g_a, g_s = jnp.split(hn @ w_in, IN_SPLITS, axis=-1)
    pos = jnp.arange(l, dtype=jnp.int32)
    q = rope(q.reshape(b, l, DA_HEADS, 2, DA_HEAD_DIM), pos)
    k = rope(k.reshape(b, l, DA_HEADS, 2, DA_HEAD_DIM), pos)
    v = v.reshape(b, l, DA_HEADS, DA_V_DIM)
    f32 = jnp.float32
    lam = (jnp.exp(jnp.sum(lambda_q1.astype(f32) * lambda_k1.astype(f32)))
           - jnp.exp(jnp.sum(lambda_q2.astype(f32) * lambda_k2.astype(f32))) + lambda_init)
    o_a = diff_attention(q, k, v, lam, subln_g, lambda_init)
    o_s = s5_mixer(u, a_re, a_im, log_dt, b_re, b_im, c_re, c_im, d_skip, w_glu)
    merged = jax.nn.sigmoid(g_a) * (o_a @ w_branch_attn) + jax.nn.sigmoid(g_s) * (o_s @ w_branch_ssm)
    return merged @ w_mix_out


def cross_attention(hn, mem_n, w_xq, w_xkv, w_xo):
    b, l, _ = hn.shape
    q = (hn @ w_xq).reshape(b, l, X_HEADS, X_HEAD_DIM)
    k, v = jnp.split(mem_n @ w_xkv, 2, axis=-1)
    k = k.reshape(b, -1, X_HEADS, X_HEAD_DIM)
    v = v.reshape(b, -1, X_HEADS, X_HEAD_DIM)
    s = jnp.einsum('bqhd,bkhd->bhqk', q, k, preferred_element_type=jnp.float32) * (X_HEAD_DIM ** -0.5)
    p = jax.nn.softmax(s, axis=-1)
    o = jnp.einsum('bhqk,bkhd->bqhd', p.astype(v.dtype), v).reshape(b, l, D_MODEL)
    return o @ w_xo


def moe_ffn(hn, w_router, b_router, w_e1, b_e1, w_e2, b_e2):
    f32 = jnp.float32
    b, l, d = hn.shape
    t = hn.reshape(-1, d)
    n_tok = t.shape[0]
    n_asg = n_tok * TOP_K
    logits = jnp.dot(t, w_router, preferred_element_type=f32) + b_router.astype(f32)
    top_v, top_i = lax.top_k(logits, TOP_K)
    gates = jax.nn.softmax(top_v, axis=-1)
    flat_e = top_i.reshape(-1).astype(jnp.int32)
    flat_tok = jnp.arange(n_asg, dtype=jnp.int32) // TOP_K
    flat_w = gates.reshape(-1)
    order = jnp.argsort(flat_e)
    sorted_e = flat_e[order]
    counts = jnp.bincount(flat_e, length=N_EXPERTS).astype(jnp.int32)
    padded = (counts + MOE_BLOCK - 1) // MOE_BLOCK * MOE_BLOCK
    pad_end = jnp.cumsum(padded)
    pad_start = pad_end - padded
    grp_start = jnp.cumsum(counts) - counts
    rank = jnp.arange(n_asg, dtype=jnp.int32) - grp_start[sorted_e]
    dest = pad_start[sorted_e] + rank
    n_pad = n_asg + N_EXPERTS * MOE_BLOCK
    n_blk = n_pad // MOE_BLOCK
    row_tok = jnp.zeros((n_pad,), jnp.int32).at[dest].set(flat_tok[order])
    row_w = jnp.zeros((n_pad,), f32).at[dest].set(flat_w[order])
    blk_start = jnp.arange(n_blk, dtype=jnp.int32) * MOE_BLOCK
    blk_e = jnp.minimum(jnp.searchsorted(pad_end, blk_start, side='right'), N_EXPERTS - 1).astype(jnp.int32)
    xs = t[row_tok].reshape(n_blk, MOE_BLOCK, d)

    def expert_block(args):
        xb, e = args
        hid = xb @ w_e1[e] + b_e1[e]
        gate = jnp.minimum(hid[:, :D_FF], SWIGLU_LIMIT)
        lin = jnp.clip(hid[:, D_FF:], -SWIGLU_LIMIT, SWIGLU_LIMIT)
        act = gate * jax.nn.sigmoid(SWIGLU_ALPHA * gate) * (lin + 1.0)
        return act @ w_e2[e] + b_e2[e]

    ys = lax.map(expert_block, (xs, blk_e)).reshape(n_pad, d)
    out = jax.ops.segment_sum(ys.astype(f32) * row_w[:, None], row_tok, num_segments=n_tok)
    return out.astype(hn.dtype).reshape(b, l, d)


def setup_inputs(seed: int = 0) -> dict:
    key = jax.random.key(seed)
    ks = iter(jax.random.split(key, 40))
    f32 = jnp.float32
    L = DEPTH
    G, P, HG = SSM_GROUPS, SSM_STATE, SSM_GROUP

    def nrm(shape, fan_in):
        return jax.random.normal(next(ks), shape, f32) * (fan_in ** -0.5)

    def gain(shape):
        return 1.0 + 0.02 * jax.random.normal(next(ks), shape, f32)

    def small(shape, s):
        return s * jax.random.normal(next(ks), shape, f32)

    n_idx = jnp.arange(SSM_STATE, dtype=f32)
    return {
        'x': jax.random.normal(next(ks), (BATCH, SEQ, D_MODEL), f32),
        'mem': jax.random.normal(next(ks), (BATCH, N_MEM, D_MODEL), f32),
        'norm_mix_g': gain((L, D_MODEL)),
        'w_in': nrm((L, D_MODEL, IN_WIDTH), D_MODEL),
        'lambda_q1': small((L, DA_HEAD_DIM), 0.1),
        'lambda_k1': small((L, DA_HEAD_DIM), 0.1),
        'lambda_q2': small((L, DA_HEAD_DIM), 0.1),
        'lambda_k2': small((L, DA_HEAD_DIM), 0.1),
        'subln_g': gain((L, DA_V_DIM)),
        'ssm_a_re': -0.5 + small((L, 2, G, P), 0.01),
        'ssm_a_im': math.pi * n_idx + small((L, 2, G, P), 0.01),
        'ssm_log_dt': jax.random.uniform(next(ks), (L, 2, G), f32, math.log(1e-3), math.log(1e-1)),
        'ssm_b_re': nrm((L, 2, G, P, HG), 2 * HG),
        'ssm_b_im': nrm((L, 2, G, P, HG), 2 * HG),
        'ssm_c_re': nrm((L, 2, G, HG, P), 2 * P),
        'ssm_c_im': nrm((L, 2, G, HG, P), 2 * P),
        'ssm_d': jax.random.normal(next(ks), (L, SSM_WIDTH), f32),
        'w_glu': nrm((L, SSM_WIDTH, 2 * SSM_WIDTH), SSM_WIDTH),
        'w_branch_attn': nrm((L, DA_WIDTH, D_MODEL), DA_WIDTH),
        'w_branch_ssm': nrm((L, SSM_WIDTH, D_MODEL), SSM_WIDTH),
        'w_mix_out': nrm((L, D_MODEL, D_MODEL), D_MODEL),
        'norm_cross_g': gain((L, D_MODEL)),
        'norm_mem_g': gain((L, D_MODEL)),
        'w_xq': nrm((L, D_MODEL, D_MODEL), D_MODEL),
        'w_xkv': nrm((L, D_MODEL, 2 * D_MODEL), D_MODEL),
        'w_xo': nrm((L, D_MODEL, D_MODEL), D_MODEL),
        'norm_ffn_g': gain((L, D_MODEL)),
        'w_router': nrm((L, D_MODEL, N_EXPERTS), D_MODEL),
        'b_router': small((L, N_EXPERTS), 0.01),
        'w_e1': nrm((L, N_EXPERTS, D_MODEL, 2 * D_FF), D_MODEL),
        'b_e1': small((L, N_EXPERTS, 2 * D_FF), 0.01),
        'w_e2': nrm((L, N_EXPERTS, D_FF, D_MODEL), D_FF),
        'b_e2': small((L, N_EXPERTS, D_MODEL), 0.01),
        'norm_final_g': gain((D_MODEL,)),
    }


def reference(x, mem, norm_mix_g, w_in, lambda_q1, lambda_k1, lambda_q2, lambda_k2, subln_g,
              ssm_a_re, ssm_a_im, ssm_log_dt, ssm_b_re, ssm_b_im, ssm_c_re, ssm_c_im, ssm_d, w_glu,
              w_branch_attn, w_branch_ssm, w_mix_out, norm_cross_g, norm_mem_g, w_xq, w_xkv, w_xo,
              norm_ffn_g, w_router, b_router, w_e1, b_e1, w_e2, b_e2, norm_final_g):
    h = x
    for layer in range(DEPTH):
        lambda_init = 0.8 - 0.6 * math.exp(-0.3 * layer)
        hn = rms_norm(h, norm_mix_g[layer])
        h = h + hybrid_mixer(hn, w_in[layer], lambda_q1[layer], lambda_k1[layer], lambda_q2[layer],
                             lambda_k2[layer], subln_g[layer], ssm_a_re[layer], ssm_a_im[layer],
                             ssm_log_dt[layer], ssm_b_re[layer], ssm_b_im[layer], ssm_c_re[layer],
                             ssm_c_im[layer], ssm_d[layer], w_glu[layer], w_branch_attn[layer],
                             w_branch_ssm[layer], w_mix_out[layer], lambda_init)
        h = h + cross_attention(rms_norm(h, norm_cross_g[layer]), rms_norm(mem, norm_mem_g[layer]),
                                w_xq[layer], w_xkv[layer], w_xo[layer])
        h = h + moe_ffn(rms_norm(h, norm_ffn_g[layer]), w_router[layer], b_router[layer],
                        w_e1[layer], b_e1[layer], w_e2[layer], b_e2[layer])
    return rms_norm(h, norm_final_g)
```

```cpp
#define PG8_PRIO 0
#include <hip/hip_runtime.h>
#include <cstdio>
#include <cstdint>

#define LAS __attribute__((address_space(3)))
#define GAS __attribute__((address_space(1)))
typedef unsigned short bf16_t;
typedef short bf16x8 __attribute__((ext_vector_type(8)));
typedef float f32x4 __attribute__((ext_vector_type(4)));
typedef float f32x2 __attribute__((ext_vector_type(2)));
typedef float f32x16 __attribute__((ext_vector_type(16)));
typedef unsigned u32x4 __attribute__((ext_vector_type(4)));
typedef unsigned u32x2 __attribute__((ext_vector_type(2)));

constexpr int NBATCH = 16, SEQ = 2048, DM = 1024, NTOK = NBATCH * SEQ;
constexpr int NMEM = 256, NMEMTOK = NBATCH * NMEM;
constexpr int NEXP = 32, TOPK = 4, NPAD = NTOK * TOPK + NEXP * 256, MAXBLK = NPAD / 256;
constexpr float EPS = 1e-6f;
constexpr float LOG2E = 1.4426950408889634f;
constexpr float QSCALE = 0.125f * LOG2E;
constexpr float XQSCALE = 0.0625f * LOG2E;
constexpr float LAMBDA_INIT = 0.2f;

constexpr size_t MiB = 1u << 20;
constexpr size_t WS_CTL = 0, CTL_ZERO_BYTES = 64 * 1024;
constexpr size_t WS_RSTD0 = 1 * MiB;
constexpr size_t WS_SS1 = 2 * MiB, WS_SS2 = 4 * MiB;
constexpr size_t WS_ROPE = 6 * MiB;
constexpr size_t WS_S5AB = 7 * MiB;
constexpr size_t WS_S5BB = WS_S5AB + 64 * 1024;
constexpr size_t WS_S5CC = WS_S5BB + 256 * 1024;
constexpr size_t WS_LAM = WS_S5CC + 256 * 1024;
constexpr size_t WS_WR = 8 * MiB;
constexpr size_t WS_TOPI = 9 * MiB, WS_GATE = WS_TOPI + 512 * 1024;
constexpr size_t WS_SLOT = 10 * MiB;
constexpr size_t WS_CNTWG = WS_SLOT + 512 * 1024;
constexpr int MOE_CAP = 32768 + 256;
constexpr size_t WS_ROWTOK = 256 * MiB, WS_ROWW = 262 * MiB, WS_RSCALE = 268 * MiB;
constexpr size_t WS_GCNT = WS_CTL + 16384;
constexpr size_t WS_WIN = 17 * MiB;
constexpr size_t WS_WGLU = 25 * MiB, WS_WBA = 26 * MiB, WS_WBS = 27 * MiB, WS_WMIX = 28 * MiB, WS_WXQ = 30 * MiB, WS_WXK = 32 * MiB, WS_WXV = 34 * MiB, WS_WXO = 36 * MiB;
constexpr size_t WS_WE1 = 38 * MiB, WS_WE2 = 166 * MiB;
constexpr size_t WS_MEMN = 232 * MiB, WS_XK = 240 * MiB, WS_XVT = 248 * MiB;
constexpr size_t WS_XB = 256 * MiB, WS_M1 = 672 * MiB;
constexpr size_t WS_Q = 320 * MiB, WS_K = 352 * MiB, WS_MG = WS_Q;
constexpr size_t WS_VT = 384 * MiB, WS_U = 416 * MiB;
constexpr size_t WS_GA = 448 * MiB, WS_XQ = WS_GA;
constexpr size_t WS_GS = 512 * MiB, WS_XO = WS_GS;
constexpr size_t WS_OAS = 576 * MiB, WS_SG = 640 * MiB, WS_YP = 672 * MiB, WS_H1B = 736 * MiB, WS_H2B = 800 * MiB;
constexpr size_t WS_XS8 = 256 * MiB;
constexpr size_t WS_ACT = 392 * MiB, WS_YS = 528 * MiB;
constexpr size_t WS_H2F8 = 864 * MiB;
constexpr size_t WS_END = 896 * MiB;
constexpr float W8SCALE = 64.0f, W8INV = 1.0f / 64.0f;
static_assert(WS_XS8 + (size_t)NPAD * 1024 <= WS_ACT && WS_ACT + (size_t)NPAD * 1024 <= WS_YS && WS_YS + (size_t)NPAD * 2048 <= WS_H2B, "overlay map");

constexpr int RING_BYTES = 131072;
constexpr int LDS_BYTES = 163840;
constexpr int PHASE_LDS = LDS_BYTES - 4096;
constexpr int MISC_OFF = PHASE_LDS;
constexpr int TAB_OFF = PHASE_LDS + 256;

__device__ __forceinline__ unsigned cvt_pk_bf16(float lo, float hi) { unsigned r; asm("v_cvt_pk_bf16_f32 %0, %1, %2" : "=v"(r) : "v"(lo), "v"(hi)); return r; }
__device__ __forceinline__ unsigned pack4_fp8(float a, float b, float c, float d) { int w = 0; w = __builtin_amdgcn_cvt_pk_fp8_f32(a, b, w, false); w = __builtin_amdgcn_cvt_pk_fp8_f32(c, d, w, true); return (unsigned)w; }
__device__ __forceinline__ float bf_lo(unsigned u) { return __uint_as_float(u << 16); }
__device__ __forceinline__ float bf_hi(unsigned u) { return __uint_as_float(u & 0xffff0000u); }
__device__ __forceinline__ float fast_sigmoid(float x) { return __builtin_amdgcn_rcpf(1.0f + __builtin_amdgcn_exp2f(-x * LOG2E)); }
__device__ __forceinline__ float wave_sum(float v) {
#pragma unroll
    for (int o = 1; o < 64; o <<= 1) v += __shfl_xor(v, o);
    return v;
}
__device__ __forceinline__ int fresh_lane() { int l; asm volatile("v_mbcnt_lo_u32_b32 %0, -1, 0\n\tv_mbcnt_hi_u32_b32 %0, -1, %0" : "=v"(l)); return l; }
#define LDS_WAIT() asm volatile("s_waitcnt lgkmcnt(0)" ::: "memory")
#define VM_WAIT() asm volatile("s_waitcnt vmcnt(0)" ::: "memory")

#define XB_TMO      128
#define XB_XCNT(j)  (256  + 64 * (j))
#define XB_XSUB(j)  (1280 + 64 * (j))
#define XB_XGEN(j)  (2304 + 64 * (j))
#define XB_TOP      3328
#define XB_TOPGEN   3392
#define XCD_BAR_WORDS 3456
#define XB_SPIN_CAP (1u << 18)
__device__ __forceinline__ unsigned xb_ld(unsigned* p)              { return __hip_atomic_load(p, __ATOMIC_RELAXED, __HIP_MEMORY_SCOPE_AGENT); }
__device__ __forceinline__ unsigned xb_add(unsigned* p, unsigned v) { return __hip_atomic_fetch_add(p, v, __ATOMIC_RELAXED, __HIP_MEMORY_SCOPE_AGENT); }
__device__ __forceinline__ unsigned xb_xcc_id() { return (unsigned)__builtin_amdgcn_s_getreg((3 << 11) | 20) & 0xFu; }
#define XB_SPIN(cond, bar) do { unsigned _sp = 0; while (cond) { __builtin_amdgcn_s_sleep(1); \
    if ((++_sp & 255u) == 0u) { if (xb_ld(&(bar)[XB_TMO])) break; if (_sp > XB_SPIN_CAP) { atomicAdd(&(bar)[XB_TMO], 1u); break; } } } } while (0)
struct XcdBarrier { unsigned* bar; unsigned x; volatile LAS unsigned* st; };
__device__ __forceinline__ XcdBarrier xcd_barrier_post(unsigned* bar, volatile LAS unsigned* st) {
    XcdBarrier b; b.bar = bar; b.x = xb_xcc_id(); b.st = st;
    if (threadIdx.x == 0) (void)xb_add(&bar[XB_XCNT(b.x)], 1u);
    return b;
}
__device__ __forceinline__ void xcd_barrier_complete(unsigned* bar, unsigned x, unsigned& nloc, unsigned& nx) {
    const unsigned G = gridDim.x * gridDim.y * gridDim.z;
    unsigned sum, cnt, mine, sp = 0u;
    for (;;) {
        sum = 0u; cnt = 0u; mine = 0u;
#pragma unroll
        for (unsigned j = 0; j < 16; ++j) { const unsigned c = xb_ld(&bar[XB_XCNT(j)]); sum += c; cnt += (c > 0u) ? 1u : 0u; mine = (j == x) ? c : mine; }
        if (sum == G) break;
        __builtin_amdgcn_s_sleep(1);
        if ((++sp & 255u) == 0u) { if (xb_ld(&bar[XB_TMO])) break; if (sp > XB_SPIN_CAP) { atomicAdd(&bar[XB_TMO], 1u); break; } }
    }
    nloc = mine > 0u ? mine : 1u; nx = cnt > 0u ? cnt : 1u;
}
__device__ __forceinline__ void xcd_barrier(const XcdBarrier& b, const int wid) {
    asm volatile("s_waitcnt vmcnt(0)" ::: "memory");
    __syncthreads();
    if (wid == 0 && fresh_lane() == 0) {
        unsigned* bar = b.bar;
        __builtin_amdgcn_s_waitcnt(0);
        unsigned nloc = b.st[0], nx = b.st[1];
        if (nloc == 0u) { xcd_barrier_complete(bar, b.x, nloc, nx); b.st[0] = nloc; b.st[1] = nx; }
        const unsigned old = xb_add(&bar[XB_XSUB(b.x)], 1u);
        const unsigned gen = old / nloc;
#ifndef XB_FLATREL
#define XB_FLATREL 0
#endif
#if XB_FLATREL
        if (old + 1u == (gen + 1u) * nloc) {
            __builtin_amdgcn_fence(__ATOMIC_RELEASE, "agent");
            asm volatile("s_waitcnt vmcnt(0)" ::: "memory");
            const unsigned og = xb_add(&bar[XB_TOP], 1u);
            const unsigned tg = og / nx;
            if (og + 1u == (tg + 1u) * nx) {
#pragma unroll
                for (unsigned j = 0; j < 16; ++j) (void)xb_add(&bar[XB_XGEN(j)], 1u);
            }
        }
        XB_SPIN(xb_ld(&bar[XB_XGEN(b.x)]) == gen, bar);
        __builtin_amdgcn_fence(__ATOMIC_ACQUIRE, "agent");
        asm volatile("s_waitcnt vmcnt(0)" ::: "memory");
#else
        if (old + 1u == (gen + 1u) * nloc) {
            __builtin_amdgcn_fence(__ATOMIC_RELEASE, "agent");
            asm volatile("s_waitcnt vmcnt(0)" ::: "memory");
            const unsigned og = xb_add(&bar[XB_TOP], 1u);
            const unsigned tg = og / nx;
            if (og + 1u == (tg + 1u) * nx) xb_add(&bar[XB_TOPGEN], 1u);
            else XB_SPIN(xb_ld(&bar[XB_TOPGEN]) == tg, bar);
            __builtin_amdgcn_fence(__ATOMIC_ACQUIRE, "agent");
            xb_add(&bar[XB_XGEN(b.x)], 1u);
            asm volatile("s_waitcnt vmcnt(0)" ::: "memory");
        } else {
            XB_SPIN(xb_ld(&bar[XB_XGEN(b.x)]) == gen, bar);
            __builtin_amdgcn_fence(__ATOMIC_ACQUIRE, "agent");
            asm volatile("s_waitcnt vmcnt(0)" ::: "memory");
        }
#endif
    }
    __syncthreads();
}

namespace pg8 {
constexpr int BM = 256, BK = 64, HALF = 128, HTB = HALF * BK * 2, NXCD = 8, WGM = 8;
__device__ __forceinline__ int lds_byte(int r, int c) { const int st = (r >> 4) * 2 + (c >> 5), rr = r & 15, cc = c & 31, ob = rr * 64 + cc * 2; return st * 1024 + (ob ^ (((ob >> 9) & 1) << 5)); }
__device__ __forceinline__ void stage_rc(int b, int& R, int& C) { const int st = b / 1024, sb = b % 1024, swz = sb ^ (((sb >> 9) & 1) << 5); R = (st >> 1) * 16 + swz / 64; C = (st & 1) * 32 + (swz % 64) / 2; }
__device__ __forceinline__ int perm32(int rho) { const int n = rho >> 4, i = rho & 15; return 8 * (i >> 2) + 4 * n + (i & 3); }

struct GUnit { const char* A; const char* B; const int* idx; int pm, pn, kind, e; };

typedef int v4i_t __attribute__((ext_vector_type(4))); typedef int v8i_t __attribute__((ext_vector_type(8)));
__device__ __forceinline__ v8i_t cat8(const bf16x8 a, const bf16x8 b) { const v4i_t x = __builtin_bit_cast(v4i_t, a), y = __builtin_bit_cast(v4i_t, b); return __builtin_shufflevector(x, y, 0, 1, 2, 3, 4, 5, 6, 7); }
__device__ __forceinline__ bf16x8 lo8(const v8i_t x) { return __builtin_bit_cast(bf16x8, (v4i_t)__builtin_shufflevector(x, x, 0, 1, 2, 3)); }
__device__ __forceinline__ bf16x8 hi8(const v8i_t x) { return __builtin_bit_cast(bf16x8, (v4i_t)__builtin_shufflevector(x, x, 4, 5, 6, 7)); }
template <int Q> __device__ __forceinline__ f32x16 ins4(const f32x16 X, const f32x4 c) {
    const f32x16 w = __builtin_shufflevector(c, c, 0, 1, 2, 3, 0, 1, 2, 3, 0, 1, 2, 3, 0, 1, 2, 3);
    if constexpr (Q == 0) return __builtin_shufflevector(X, w, 16, 17, 18, 19, 4, 5, 6, 7, 8, 9, 10, 11, 12, 13, 14, 15);
    else if constexpr (Q == 1) return __builtin_shufflevector(X, w, 0, 1, 2, 3, 16, 17, 18, 19, 8, 9, 10, 11, 12, 13, 14, 15);
    else if constexpr (Q == 2) return __builtin_shufflevector(X, w, 0, 1, 2, 3, 4, 5, 6, 7, 16, 17, 18, 19, 12, 13, 14, 15);
    else return __builtin_shufflevector(X, w, 0, 1, 2, 3, 4, 5, 6, 7, 8, 9, 10, 11, 16, 17, 18, 19);
}
__device__ __forceinline__ void glds16_s(const char* sbase, const unsigned voff, const unsigned lds_dst) {
    unsigned keep;
    asm volatile("s_mov_b32 %0, m0\n\ts_mov_b32 m0, %3\n\ts_nop 0\n\tglobal_load_lds_dwordx4 %1, %2\n\ts_mov_b32 m0, %0" : "=&s"(keep) : "v"(voff), "s"(sbase), "s"(lds_dst) : "memory");
}
__device__ __forceinline__ void tile_order(int wgid, int nM, int nN, int& pm, int& pn) {
    const int nwg = nM * nN; { const int q = nwg / NXCD, r = nwg % NXCD, xcd = wgid % NXCD, off = wgid / NXCD; wgid = (xcd < r ? xcd * (q + 1) : r * (q + 1) + (xcd - r) * q) + off; }
    const int nig = WGM * nN, gid = wgid / nig, fm = gid * WGM, gsz = (nM - fm) < WGM ? (nM - fm) : WGM;
    pm = fm + ((wgid % nig) % gsz); pn = (wgid % nig) / gsz;
}

struct NoMid { };
template <class T, class = void> struct EpiHasPf { static constexpr bool v = false; };
template <class T> struct EpiHasPf<T, decltype((void)T::HAS_PF)> { static constexpr bool v = true; };
constexpr int EPF_OFF = RING_BYTES;
template <class Epi, class Sched, bool GATHER, bool FP8 = false, bool ATILED = false, bool CADJ = false, class Mid = NoMid>
__device__ __forceinline__ void gemm_phase(LAS unsigned char* lds, const int wid, const int lda, const int ldb, const int K, const Sched& S, const Epi& E, const Mid& MH = Mid{}) {
    const int lane = fresh_lane(), tid = wid * 64 + lane, wr = wid >> 2, wc = wid & 3, fr = lane & 15, fq = lane >> 4;
    const int nt = K / BK;
    unsigned vA0[2], vA1[2], voffB[2];
#pragma unroll
    for (int i = 0; i < 2; ++i) { int R, C; stage_rc(tid * 16 + i * 8192, R, C); const int Rb = (R & ~31) + perm32(R & 31);
        if constexpr (ATILED) { vA0[i] = (unsigned)((C >> 3) * 4096 + R * 16); vA1[i] = vA0[i] + 2048u; }
        else { vA0[i] = (unsigned)(R * lda + C) * 2u; vA1[i] = vA0[i] + (unsigned)(HALF * lda) * 2u; }
        if constexpr (CADJ) voffB[i] = (unsigned)((64 * ((Rb >> 5) & 3) + 16 * ((Rb >> 3) & 3) + (Rb & 7)) * ldb + C) * 2u; else voffB[i] = (unsigned)(Rb * ldb + C) * 2u; }
    const size_t kstep = (size_t)(BK * 2), kstepA = ATILED ? (size_t)32768 : kstep;
    const size_t hstepB = CADJ ? (size_t)8 * ldb * 2 : (size_t)HALF * ldb * 2;
    const unsigned ldsw = (unsigned)wid * 1024u;
    const int aoff = lds_byte(wr * 64 + fr, fq * 8), boff = lds_byte(wc * 32 + fr, fq * 8);
#define PG8_SA(b, h) (((b) * 2 + (h)) * HTB)
#define PG8_SB(b, h) ((4 + (b) * 2 + (h)) * HTB)
#define PG8_STAGE(bufoff, gbase, voff) do { _Pragma("unroll") for (int _i = 0; _i < 2; ++_i) \
        glds16_s((const char*)(gbase), (voff)[_i], (unsigned)(uintptr_t)(lds + (bufoff) + ldsw + _i * 8192)); } while (0)
#define PG8_LDA(dst, b, h) do { _Pragma("unroll") for (int m = 0; m < 4; ++m) dst[m] = cat8(*(const LAS bf16x8*)(lds + PG8_SA(b, h) + aoff + m * 2048), *(const LAS bf16x8*)(lds + PG8_SA(b, h) + aoff + m * 2048 + 1024)); } while (0)
#define PG8_LDB(dst, b, h) do { _Pragma("unroll") for (int n = 0; n < 2; ++n) dst[n] = cat8(*(const LAS bf16x8*)(lds + PG8_SB(b, h) + boff + n * 2048), *(const LAS bf16x8*)(lds + PG8_SB(b, h) + boff + n * 2048 + 1024)); } while (0)
#define PG8_Q(X, q) ((f32x4)__builtin_shufflevector(X, X, 4 * (q), 4 * (q) + 1, 4 * (q) + 2, 4 * (q) + 3))
#define PG8_MM1(X, q, m, n, At, Bt) do { f32x4 c_ = PG8_Q(X, q); \
        if constexpr (FP8) c_ = __builtin_amdgcn_mfma_scale_f32_16x16x128_f8f6f4(Bt[n], At[m], c_, 0, 0, 0, 0x7f7f7f7f, 0, 0x7f7f7f7f); \
        else { c_ = __builtin_amdgcn_mfma_f32_16x16x32_bf16(lo8(Bt[n]), lo8(At[m]), c_, 0, 0, 0); c_ = __builtin_amdgcn_mfma_f32_16x16x32_bf16(hi8(Bt[n]), hi8(At[m]), c_, 0, 0, 0); } \
        X = ins4<q>(X, c_); } while (0)
#ifndef PG8_PRIO
#define PG8_PRIO 1
#endif
#define PG8_MMA(ai, bj, At, Bt) do { if (PG8_PRIO) __builtin_amdgcn_s_setprio(1); \
        PG8_MM1(acc16[ai][bj][0], 0, 0, 0, At, Bt); PG8_MM1(acc16[ai][bj][0], 1, 0, 1, At, Bt); PG8_MM1(acc16[ai][bj][0], 2, 1, 0, At, Bt); PG8_MM1(acc16[ai][bj][0], 3, 1, 1, At, Bt); \
        PG8_MM1(acc16[ai][bj][1], 0, 2, 0, At, Bt); PG8_MM1(acc16[ai][bj][1], 1, 2, 1, At, Bt); PG8_MM1(acc16[ai][bj][1], 2, 3, 0, At, Bt); PG8_MM1(acc16[ai][bj][1], 3, 3, 1, At, Bt); \
        if (PG8_PRIO) __builtin_amdgcn_s_setprio(0); } while (0)
#define PG8_WAIT_V(n) asm volatile("s_waitcnt vmcnt(" #n ")" ::: "memory")
#define PG8_WAIT_L(n) asm volatile("s_waitcnt lgkmcnt(" #n ")" ::: "memory")
#define PG8_BAR __builtin_amdgcn_s_barrier()
#define PG8_SCHED __builtin_amdgcn_sched_barrier(0)
#define PG8_GIDX(dst0, dst1, u) do { const int R0_ = (wid >> 1) * 16 + (lane >> 2); const unsigned Cb_ = (unsigned)(((wid & 1) * 32 + (((lane & 3) * 8) ^ (((lane >> 5) & 1) << 4))) * 2); \
        _Pragma("unroll") for (int _i = 0; _i < 2; ++_i) { dst0[_i] = (unsigned)(u).idx[R0_ + 64 * _i] * (unsigned)(lda * 2) + Cb_; dst1[_i] = (unsigned)(u).idx[HALF + R0_ + 64 * _i] * (unsigned)(lda * 2) + Cb_; } } while (0)
    GUnit cur, nxt; int ui = 0;
    if (!S.next(0, cur)) return;
    f32x16 acc16[2][2][2];
#define PG8_ZERO() do { _Pragma("unroll") for (int a = 0; a < 2; ++a) _Pragma("unroll") for (int b = 0; b < 2; ++b) _Pragma("unroll") for (int h = 0; h < 2; ++h) _Pragma("unroll") for (int r = 0; r < 16; ++r) acc16[a][b][h][r] = 0.f; } while (0)
    PG8_ZERO();
    v8i_t At[4], B0[2], B1[2];
    const char* cA = cur.A; const char* cB = cur.B;
    int pfs = 0;
    if constexpr (EpiHasPf<Epi>::v) { const float v0_ = E.pf_load(cur, tid, wid); ((LAS float*)(lds + EPF_OFF))[tid] = v0_; }
    if constexpr (GATHER) { PG8_GIDX(vA0, vA1, cur); VM_WAIT(); }
    PG8_STAGE(PG8_SB(0, 0), cB, voffB); PG8_STAGE(PG8_SB(0, 1), cB + hstepB, voffB); PG8_STAGE(PG8_SA(0, 0), cA, vA0); PG8_STAGE(PG8_SA(0, 1), cA, vA1);
    if (wr == 1) PG8_BAR;
    PG8_WAIT_V(2); PG8_BAR;
    PG8_STAGE(PG8_SB(1, 0), cB + kstep, voffB); PG8_STAGE(PG8_SA(1, 0), cA + kstepA, vA0); PG8_STAGE(PG8_SB(1, 1), cB + hstepB + kstep, voffB);
    PG8_WAIT_V(6); PG8_BAR;
    for (;;) {
        const bool has_next = S.next(ui + 1, nxt);
        const char* nA = has_next ? nxt.A : cA; const char* nB = has_next ? nxt.B : cB;
#pragma unroll 1
        for (int t = 0; t < nt; t += 2) {
            const bool last = (t == nt - 2);
            if constexpr (!__is_same(Mid, NoMid)) { if (t == (nt >> 1)) MH(acc16, cur, wr, wc, fr, fq); }
            const char* a1 = cA + (size_t)(t + 1) * kstepA;
            const char* a2 = last ? nA : cA + (size_t)(t + 2) * kstepA; const char* b2 = last ? nB : cB + (size_t)(t + 2) * kstep;
            const char* a3 = a2 + kstepA; const char* b3 = b2 + kstep;
            PG8_LDB(B0, 0, 0); PG8_LDB(B1, 0, 1); PG8_SCHED; PG8_LDA(At, 0, 0); PG8_STAGE(PG8_SA(1, 1), a1, vA1);
            if constexpr (GATHER) { if (last && has_next) PG8_GIDX(vA0, vA1, nxt); }
            PG8_WAIT_V(8); PG8_WAIT_L(0); PG8_BAR; PG8_MMA(0, 0, At, B0); PG8_MMA(0, 1, At, B1); PG8_BAR; PG8_SCHED;
            PG8_LDA(At, 0, 1); PG8_STAGE(PG8_SB(0, 0), b2, voffB); PG8_STAGE(PG8_SB(0, 1), b2 + hstepB, voffB); PG8_STAGE(PG8_SA(0, 0), a2, vA0);
            PG8_WAIT_V(8); PG8_WAIT_L(0); PG8_BAR; PG8_MMA(1, 0, At, B0); PG8_MMA(1, 1, At, B1); PG8_BAR; PG8_SCHED;
            PG8_LDB(B0, 1, 0); PG8_LDB(B1, 1, 1); PG8_SCHED; PG8_LDA(At, 1, 0); PG8_STAGE(PG8_SA(0, 1), a2, vA1);
            PG8_WAIT_V(8); PG8_WAIT_L(0); PG8_BAR; PG8_MMA(0, 0, At, B0); PG8_MMA(0, 1, At, B1); PG8_BAR; PG8_SCHED;
            PG8_LDA(At, 1, 1); PG8_STAGE(PG8_SB(1, 0), b3, voffB); PG8_STAGE(PG8_SB(1, 1), b3 + hstepB, voffB); PG8_STAGE(PG8_SA(1, 0), a3, vA0);
            PG8_WAIT_V(8); PG8_WAIT_L(0); PG8_BAR; PG8_MMA(1, 0, At, B0); PG8_MMA(1, 1, At, B1); PG8_BAR; PG8_SCHED;
        }
        float pfv = 0.f;
        if constexpr (EpiHasPf<Epi>::v) { if (has_next) pfv = E.pf_load_async(nxt, tid, wid); }
        if (wr == 0) PG8_BAR;
        { f32x4 acc[2][2][4][2];
#pragma unroll
          for (int a = 0; a < 2; ++a)
#pragma unroll
              for (int b = 0; b < 2; ++b)
#pragma unroll
                  for (int m = 0; m < 4; ++m)
#pragma unroll
                      for (int n = 0; n < 2; ++n)
#pragma unroll
                          for (int j = 0; j < 4; ++j) acc[a][b][m][n][j] = acc16[a][b][m >> 1][((m & 1) * 2 + n) * 4 + j];
          if constexpr (EpiHasPf<Epi>::v) E.run(acc, cur, wr, wc, fr, fq, (const LAS float*)(lds + EPF_OFF + pfs * 2048)); else E(acc, cur, wr, wc, fr, fq); }
        if constexpr (EpiHasPf<Epi>::v) { if (has_next) { E.pf_wait(pfv); ((LAS float*)(lds + EPF_OFF + (pfs ^ 1) * 2048))[tid] = pfv; pfs ^= 1; } }
        if (!has_next) break;
        PG8_ZERO();
        cur = nxt; cA = nA; cB = nB; ++ui;
        if (wr == 1) PG8_BAR;
    }
    PG8_WAIT_V(0);
    PG8_BAR;
#undef PG8_SA
#undef PG8_SB
#undef PG8_STAGE
#undef PG8_LDA
#undef PG8_LDB
#undef PG8_MMA
#undef PG8_WAIT_V
#undef PG8_WAIT_L
#undef PG8_BAR
#undef PG8_SCHED
#undef PG8_GIDX
#undef PG8_ZERO
#undef PG8_Q
#undef PG8_MM1
}
}
using pg8::GUnit;
enum { K_Q = 0, K_K = 1, K_U = 2, K_GA = 3, K_GS = 4, K_VT = 5, K_XK = 6, K_XVT = 7 };
typedef f32x4 Acc[2][2][4][2];

__device__ __forceinline__ u32x4 pack8(const f32x4 a, const f32x4 b) { u32x4 w; w.x = cvt_pk_bf16(a[0], a[1]); w.y = cvt_pk_bf16(a[2], a[3]); w.z = cvt_pk_bf16(b[0], b[1]); w.w = cvt_pk_bf16(b[2], b[3]); return w; }
__device__ __forceinline__ void unpack8(const u32x4 w, f32x4& a, f32x4& b) { a = (f32x4){bf_lo(w.x), bf_hi(w.x), bf_lo(w.y), bf_hi(w.y)}; b = (f32x4){bf_lo(w.z), bf_hi(w.z), bf_lo(w.w), bf_hi(w.w)}; }
__device__ __forceinline__ f32x4 sig4(const f32x4 v) { return (f32x4){fast_sigmoid(v[0]), fast_sigmoid(v[1]), fast_sigmoid(v[2]), fast_sigmoid(v[3])}; }
__device__ __forceinline__ void store_pair16(bf16_t* blk, const size_t ld, const u32x4 c0, const u32x4 c1, const int k0, const int k1, const int fr) {
    u32x4 r1, dA, dB; const bool lo = fr < 8;
#pragma unroll
    for (int k = 0; k < 4; ++k) { r1[k] = (unsigned)__builtin_amdgcn_update_dpp(0, (int)c1[k], 0x128  , 0xF, 0xF, false); dA[k] = lo ? c0[k] : r1[k]; dB[k] = lo ? r1[k] : c0[k]; }
    *(u32x4*)(blk + (size_t)(fr & 7) * ld + (lo ? k0 : k1) * 8) = dA;
    *(u32x4*)(blk + (size_t)(8 + (fr & 7)) * ld + (lo ? k1 : k0) * 8) = dB;
}
__device__ __forceinline__ float row_rstd16(const float* ssp, int row) {
    const f32x4* p = (const f32x4*)(ssp + (size_t)row * 16); const f32x4 a = p[0], b = p[1], c = p[2], d = p[3];
    const float s = ((a[0] + a[1]) + (a[2] + a[3])) + ((b[0] + b[1]) + (b[2] + b[3])) + ((c[0] + c[1]) + (c[2] + c[3])) + ((d[0] + d[1]) + (d[2] + d[3]));
    return __builtin_amdgcn_rsqf(s * (1.0f / DM) + EPS);
}

struct EpiP1 {
    unsigned char* ws; const float* rstd0; const float* rope;
    __device__ __forceinline__ void operator()(const Acc& acc, const GUnit& u, int wr, int wc, int fr, int fq) const {
        const int kind = u.kind, row0 = u.pm * 256 + wr * 64 + fr;
        if (kind <= K_K) {
            bf16_t* O = (bf16_t*)(ws + ((kind == K_Q) ? WS_Q : WS_K)); const float sc = (kind == K_Q) ? QSCALE : 1.0f;
            const int cb = (u.pn & 1) * 256 + wc * 64 + fq * 8;
#pragma unroll
            for (int ai = 0; ai < 2; ++ai) {
                float rsv[4]; f32x4 rq[4][4];
#pragma unroll
                for (int m = 0; m < 4; ++m) { const int row = row0 + ai * 128 + m * 16; rsv[m] = rstd0[row];
                    const f32x4* rp = (const f32x4*)(rope + ((size_t)(row & (SEQ - 1)) * 32 + fq * 8) * 2); rq[m][0] = rp[0]; rq[m][1] = rp[1]; rq[m][2] = rp[2]; rq[m][3] = rp[3]; }
                __builtin_amdgcn_sched_barrier(0);
#pragma unroll
                for (int m = 0; m < 4; ++m) {
                    const int row = row0 + ai * 128 + m * 16; const float rs = rsv[m] * sc;
                    const f32x4 r0 = rq[m][0], r1 = rq[m][1], r2 = rq[m][2], r3 = rq[m][3];
                    const f32x4 a0 = acc[ai][0][m][0] * rs, a1 = acc[ai][0][m][1] * rs, b0 = acc[ai][1][m][0] * rs, b1 = acc[ai][1][m][1] * rs;
                    const f32x4 c0 = (f32x4){r0[0], r0[2], r1[0], r1[2]}, s0 = (f32x4){r0[1], r0[3], r1[1], r1[3]}, c1 = (f32x4){r2[0], r2[2], r3[0], r3[2]}, s1 = (f32x4){r2[1], r2[3], r3[1], r3[3]};
                    const f32x4 o1a = a0 * c0 - b0 * s0, o1b = a1 * c1 - b1 * s1, o2a = b0 * c0 + a0 * s0, o2b = b1 * c1 + a1 * s1;
                    store_pair16(O + (size_t)(row - fr) * 512 + (u.pn & 1) * 256 + wc * 64, 512, pack8(o1a, o1b), pack8(o2a, o2b), fq, 4 + fq, fr);
                }
            }
        } else if (kind <= K_GS) {
            int cb, ld; size_t wo;
            if (kind == K_U) { wo = WS_U; cb = (u.pn - 4) * 256; ld = 512; } else if (kind == K_GA) { wo = WS_GA; cb = (u.pn - 6) * 256; ld = 1024; } else { wo = WS_GS; cb = (u.pn - 10) * 256; ld = 1024; }
            bf16_t* O = (bf16_t*)(ws + wo);
            cb += wc * 64;
            float rsv[8];
#pragma unroll
            for (int i = 0; i < 8; ++i) rsv[i] = rstd0[row0 + (i >> 2) * 128 + (i & 3) * 16];
            __builtin_amdgcn_sched_barrier(0);
#pragma unroll
            for (int ai = 0; ai < 2; ++ai)
#pragma unroll
                for (int m = 0; m < 4; ++m) {
                    const int row = row0 + ai * 128 + m * 16; const float rs = rsv[ai * 4 + m]; u32x4 ch[2];
#pragma unroll
                    for (int bj = 0; bj < 2; ++bj) {
                        f32x4 v0 = acc[ai][bj][m][0] * rs, v1 = acc[ai][bj][m][1] * rs;
                        if (kind != K_U) { v0 = sig4(v0); v1 = sig4(v1); }
                        ch[bj] = pack8(v0, v1);
                    }
                    store_pair16(O + (size_t)(row - fr) * ld + cb, ld, ch[0], ch[1], 2 * fq, 2 * fq + 1, fr);
                }
        } else {
            bf16_t* O = (bf16_t*)(ws + ((kind == K_VT) ? WS_VT : (kind == K_XK ? WS_XK : WS_XVT))); const int ld = (kind == K_VT) ? NTOK : (kind == K_XK ? 1024 : NMEMTOK);
            const int cb = u.pn * 256 + wc * 64 + fq * 16;
            f32x4 cs[2][2];
#pragma unroll
            for (int bj = 0; bj < 2; ++bj) { if (kind == K_VT) { cs[bj][0] = *(const f32x4*)(rstd0 + cb + bj * 8); cs[bj][1] = *(const f32x4*)(rstd0 + cb + bj * 8 + 4); } else { cs[bj][0] = (f32x4){1.f, 1.f, 1.f, 1.f}; cs[bj][1] = cs[bj][0]; } }
#pragma unroll
            for (int ai = 0; ai < 2; ++ai)
#pragma unroll
                for (int m = 0; m < 4; ++m) {
                    const int row = row0 + ai * 128 + m * 16;
                    store_pair16(O + (size_t)(row - fr) * ld + u.pn * 256 + wc * 64, ld, pack8(acc[ai][0][m][0] * cs[0][0], acc[ai][0][m][1] * cs[0][1]), pack8(acc[ai][1][m][0] * cs[1][0], acc[ai][1][m][1] * cs[1][1]), 2 * fq, 2 * fq + 1, fr);
                }
        }
    }
};
struct EpiGlu {
    bf16_t* OAS;
    __device__ __forceinline__ void operator()(const Acc& acc, const GUnit& u, int wr, int wc, int fr, int fq) const {
        const int row0 = u.pm * 256 + wr * 64 + fr, cb = 512 + u.pn * 128 + wc * 32 + fq * 8;
#pragma unroll
        for (int ai = 0; ai < 2; ++ai)
#pragma unroll
            for (int m = 0; m < 4; ++m) { const int row = row0 + ai * 128 + m * 16;
                *(u32x4*)(OAS + (size_t)row * 1024 + cb) = pack8(acc[ai][0][m][0] * sig4(acc[ai][1][m][0]), acc[ai][0][m][1] * sig4(acc[ai][1][m][1])); }
    }
};
#ifndef PROBE_PITCH
#define PROBE_PITCH 1024
#endif
template <int MODE> struct EpiProbe {
    bf16_t* OAS;
    __device__ __forceinline__ void operator()(const Acc& acc, const GUnit& u, int wr, int wc, int fr, int fq) const {
        const int row0 = u.pm * 256 + wr * 64 + fr, cb = 512 + u.pn * 128 + wc * 32 + fq * 8;
        if (MODE == 3) {
#pragma unroll
            for (int ai = 0; ai < 2; ++ai)
#pragma unroll
                for (int m = 0; m < 4; ++m)
#pragma unroll
                    for (int hh = 0; hh < 2; ++hh) { const int row = u.pm * 256 + wr * 64 + ai * 128 + m * 16 + hh * 8 + (fr & 7), cc = 512 + u.pn * 128 + ((wc >> 1) * 64) + (fq * 2 + (fr >> 3)) * 8;
                        if ((wc & 1) == hh) *(u32x4*)(OAS + (size_t)row * PROBE_PITCH + cc) = pack8(acc[ai][0][m][0] + acc[ai][1][m][0], acc[ai][0][m][1] + acc[ai][1][m][1]); }
        } else if (MODE == 1) {
#pragma unroll
            for (int ai = 0; ai < 2; ++ai)
#pragma unroll
                for (int m = 0; m < 4; ++m) { const int row = row0 + ai * 128 + m * 16;
                    *(u32x4*)(OAS + (size_t)row * PROBE_PITCH + cb) = pack8(acc[ai][0][m][0] + acc[ai][1][m][0], acc[ai][0][m][1] + acc[ai][1][m][1]); }
        } else { f32x4 s = (f32x4){0.f, 0.f, 0.f, 0.f};
#pragma unroll
            for (int ai = 0; ai < 2; ++ai)
#pragma unroll
                for (int bj = 0; bj < 2; ++bj)
#pragma unroll
                    for (int m = 0; m < 4; ++m) s += acc[ai][bj][m][0] + acc[ai][bj][m][1];
            if (s[0] + s[1] + s[2] + s[3] == 123456.789f) OAS[(size_t)row0 * 1024 + cb] = 1; }
    }
};
template <int MODE> struct EpiBranch {
    const bf16_t* G; const bf16_t* P; bf16_t* O;
    __device__ __forceinline__ void operator()(const Acc& acc, const GUnit& u, int wr, int wc, int fr, int fq) const {
        const int row0 = u.pm * 256 + wr * 64 + fr, cb = u.pn * 256 + wc * 64 + fq * 16;
#pragma unroll
        for (int ai = 0; ai < 2; ++ai) {
            u32x4 gw[4][2], pw[4][2];
#pragma unroll
            for (int m = 0; m < 4; ++m)
#pragma unroll
                for (int bj = 0; bj < 2; ++bj) { const size_t off = (size_t)(row0 + ai * 128 + m * 16) * 1024 + cb + bj * 8; gw[m][bj] = *(const u32x4*)(G + off); if (MODE == 1) pw[m][bj] = *(const u32x4*)(P + off); }
            __builtin_amdgcn_sched_barrier(0);
#pragma unroll
            for (int m = 0; m < 4; ++m) { u32x4 ch[2];
#pragma unroll
                for (int bj = 0; bj < 2; ++bj) { f32x4 g0, g1; unpack8(gw[m][bj], g0, g1);
                    f32x4 v0 = g0 * acc[ai][bj][m][0], v1 = g1 * acc[ai][bj][m][1];
                    if (MODE == 1) { f32x4 p0, p1; unpack8(pw[m][bj], p0, p1); v0 += p0; v1 += p1; }
                    ch[bj] = pack8(v0, v1); }
                store_pair16(O + (size_t)(row0 - fr + ai * 128 + m * 16) * 1024 + u.pn * 256 + wc * 64, 1024, ch[0], ch[1], 2 * fq, 2 * fq + 1, fr); }
        }
    }
};
constexpr float GATE_TINY = 9.094947017729282e-13f;
template <int MCH> struct MidGateT {
    const bf16_t* GA; const bf16_t* GS;
    __device__ __forceinline__ void operator()(f32x16 (&acc16)[2][2][2], const GUnit& u, int wr, int wc, int fr, int fq) const {
        const unsigned vo = (unsigned)((u.pm * 256 + wr * 64 + fr) * 1024 + u.pn * 256 + wc * 64 + fq * 16) * 2u;
        const char* ga_ = (const char*)GA; const char* gs_ = (const char*)GS;
#pragma unroll
        for (int ai = 0; ai < 2; ++ai)
#pragma unroll
            for (int mc = 0; mc < 4; mc += MCH) { u32x4 ga[MCH][2], gs[MCH][2];
                unsigned vq = vo + (unsigned)((ai * 128 + mc * 16) * 2048); asm volatile("" : "+v"(vq));
#pragma unroll
                for (int mm = 0; mm < MCH; ++mm)
#pragma unroll
                    for (int bj = 0; bj < 2; ++bj) { const unsigned off = vq + (unsigned)(mm * 16 * 2048 + bj * 16); ga[mm][bj] = *(const u32x4*)(ga_ + off); gs[mm][bj] = *(const u32x4*)(gs_ + off); }
                __builtin_amdgcn_sched_barrier(0);
#pragma unroll
                for (int mm = 0; mm < MCH; ++mm) { const int m = mc + mm;
#pragma unroll
                    for (int bj = 0; bj < 2; ++bj) { f32x4 g0, g1, s0, s1; unpack8(ga[mm][bj], g0, g1); unpack8(gs[mm][bj], s0, s1);
#pragma unroll
                        for (int j = 0; j < 4; ++j) { acc16[ai][bj][m >> 1][((m & 1) * 2 + 0) * 4 + j] *= g0[j] * __builtin_amdgcn_rcpf(fmaxf(s0[j], GATE_TINY)); acc16[ai][bj][m >> 1][((m & 1) * 2 + 1) * 4 + j] *= g1[j] * __builtin_amdgcn_rcpf(fmaxf(s1[j], GATE_TINY)); } } }
                __builtin_amdgcn_sched_barrier(0);
            }
    }
};
#ifndef MID_MCH
#define MID_MCH 4
#endif
typedef MidGateT<MID_MCH> MidGate;
struct EpiGateOut {
    const bf16_t* GS; bf16_t* O;
    __device__ __forceinline__ void operator()(const Acc& acc, const GUnit& u, int wr, int wc, int fr, int fq) const {
        const int row0 = u.pm * 256 + wr * 64 + fr, cb = u.pn * 256 + wc * 64 + fq * 16;
        u32x4 gw[2][4][2];
#pragma unroll
        for (int ai = 0; ai < 2; ++ai)
#pragma unroll
            for (int m = 0; m < 4; ++m)
#pragma unroll
                for (int bj = 0; bj < 2; ++bj) gw[ai][m][bj] = *(const u32x4*)(GS + (size_t)(row0 + ai * 128 + m * 16) * 1024 + cb + bj * 8);
        __builtin_amdgcn_sched_barrier(0);
#pragma unroll
        for (int ai = 0; ai < 2; ++ai) {
#pragma unroll
            for (int m = 0; m < 4; ++m) { u32x4 ch[2];
#pragma unroll
                for (int bj = 0; bj < 2; ++bj) { f32x4 g0, g1; unpack8(gw[ai][m][bj], g0, g1);
#pragma unroll
                    for (int j = 0; j < 4; ++j) { g0[j] = fmaxf(g0[j], GATE_TINY); g1[j] = fmaxf(g1[j], GATE_TINY); }
                    ch[bj] = pack8(g0 * acc[ai][bj][m][0], g1 * acc[ai][bj][m][1]); }
                store_pair16(O + (size_t)(row0 - fr + ai * 128 + m * 16) * 1024 + u.pn * 256 + wc * 64, 1024, ch[0], ch[1], 2 * fq, 2 * fq + 1, fr); }
        }
    }
};
template <bool BASE_F32, bool WITH8 = !BASE_F32> struct EpiResid {
    const void* base; bf16_t* O; float* ssp; unsigned char* O8;
    static_assert(!BASE_F32, "the residual base is a bf16 tensor");
    __device__ __forceinline__ void operator()(const Acc& acc, const GUnit& u, int wr, int wc, int fr, int fq) const {
        const int row0 = u.pm * 256 + wr * 64 + fr, cb = u.pn * 256 + wc * 64 + fq * 16;
        u32x4 bw[2][4][2];
#pragma unroll
        for (int ai = 0; ai < 2; ++ai)
#pragma unroll
            for (int m = 0; m < 4; ++m)
#pragma unroll
                for (int bj = 0; bj < 2; ++bj) bw[ai][m][bj] = *(const u32x4*)((const bf16_t*)base + (size_t)(row0 + ai * 128 + m * 16) * 1024 + cb + bj * 8);
        __builtin_amdgcn_sched_barrier(0);
#pragma unroll
        for (int ai = 0; ai < 2; ++ai) {
#pragma unroll
            for (int m = 0; m < 4; ++m) { const int row = row0 + ai * 128 + m * 16; const size_t off = (size_t)row * 1024 + cb; float s = 0.f; u32x4 ch[2];
#pragma unroll
                for (int bj = 0; bj < 2; ++bj) { f32x4 b0, b1; unpack8(bw[ai][m][bj], b0, b1);
                    const f32x4 v0 = b0 + acc[ai][bj][m][0], v1 = b1 + acc[ai][bj][m][1];
                    s += (v0[0] * v0[0] + v0[1] * v0[1]) + (v0[2] * v0[2] + v0[3] * v0[3]) + (v1[0] * v1[0] + v1[1] * v1[1]) + (v1[2] * v1[2] + v1[3] * v1[3]);
                    ch[bj] = pack8(v0, v1);
                    if (WITH8) *(u32x2*)(O8 + off + bj * 8) = (u32x2){pack4_fp8(v0[0], v0[1], v0[2], v0[3]), pack4_fp8(v1[0], v1[1], v1[2], v1[3])}; }
                store_pair16(O + (size_t)(row - fr) * 1024 + u.pn * 256 + wc * 64, 1024, ch[0], ch[1], 2 * fq, 2 * fq + 1, fr);
                s += __shfl_xor(s, 16); s += __shfl_xor(s, 32);
                if (fq == 0) ssp[(size_t)row * 16 + u.pn * 4 + wc] = s; }
        }
    }
};
struct EpiXq {
    bf16_t* O; const float* ssp;
    __device__ __forceinline__ void operator()(const Acc& acc, const GUnit& u, int wr, int wc, int fr, int fq) const {
        const int row0 = u.pm * 256 + wr * 64 + fr;
#pragma unroll
        for (int ai = 0; ai < 2; ++ai) {
            f32x4 sp[4][4];
#pragma unroll
            for (int m = 0; m < 4; ++m) { const f32x4* p = (const f32x4*)(ssp + (size_t)(row0 + ai * 128 + m * 16) * 16); sp[m][0] = p[0]; sp[m][1] = p[1]; sp[m][2] = p[2]; sp[m][3] = p[3]; }
            __builtin_amdgcn_sched_barrier(0);
#pragma unroll
            for (int m = 0; m < 4; ++m) { const int row = row0 + ai * 128 + m * 16; const f32x4 a = sp[m][0], b = sp[m][1], c = sp[m][2], d = sp[m][3];
                const float sm = ((a[0] + a[1]) + (a[2] + a[3])) + ((b[0] + b[1]) + (b[2] + b[3])) + ((c[0] + c[1]) + (c[2] + c[3])) + ((d[0] + d[1]) + (d[2] + d[3]));
                const float rs = __builtin_amdgcn_rsqf(sm * (1.0f / DM) + EPS) * XQSCALE;
                store_pair16(O + (size_t)(row - fr) * 1024 + u.pn * 256 + wc * 64, 1024, pack8(acc[ai][0][m][0] * rs, acc[ai][0][m][1] * rs), pack8(acc[ai][1][m][0] * rs, acc[ai][1][m][1] * rs), 2 * fq, 2 * fq + 1, fr); }
        }
    }
};
struct EpiE1 {
    unsigned char* ACT; const float* rscale; const float* b1;
    __device__ __forceinline__ void operator()(const Acc& acc, const GUnit& u, int wr, int wc, int fr, int fq) const {
        const int row0 = u.pm * 256 + wr * 64 + fr, cc = u.pn * 128 + wc * 32 + fq * 8; const float* bb = b1 + (size_t)u.e * 2048 + cc;
        const f32x4 bg0 = *(const f32x4*)bb, bg1 = *(const f32x4*)(bb + 4), bl0 = *(const f32x4*)(bb + 1024), bl1 = *(const f32x4*)(bb + 1028);
        unsigned char* abase = ACT + (size_t)u.pm * 262144 + u.pn * 32768; const unsigned alo = (unsigned)((2 * wc + (fq >> 1)) * 4096 + (fq & 1) * 8 + (wr * 64 + fr) * 16);
        float rsv[8];
#pragma unroll
        for (int i = 0; i < 8; ++i) rsv[i] = rscale[u.kind + wr * 64 + fr + (i >> 2) * 128 + (i & 3) * 16] * W8INV;
        constexpr float KS = 1.702f * LOG2E, KI = 1.0f / KS;
        const f32x4 bgk0 = bg0 * -KS, bgk1 = bg1 * -KS, blk0 = (bl0 + 1.0f) * -KI, blk1 = (bl1 + 1.0f) * -KI;
        __builtin_amdgcn_sched_barrier(0);
#pragma unroll
        for (int ai = 0; ai < 2; ++ai)
#pragma unroll
            for (int m = 0; m < 4; ++m) { const float rs = rsv[ai * 4 + m], rsg = rs * -KS, rsl = rs * -KI;
                f32x4 g0 = acc[ai][0][m][0] * rsg + bgk0, g1 = acc[ai][0][m][1] * rsg + bgk1, l0 = acc[ai][1][m][0] * rsl + blk0, l1 = acc[ai][1][m][1] * rsl + blk1, d0, d1, o0, o1;
#pragma unroll
                for (int j = 0; j < 4; ++j) { g0[j] = fmaxf(g0[j], -7.0f * KS); g1[j] = fmaxf(g1[j], -7.0f * KS); l0[j] = fminf(fmaxf(l0[j], -8.0f * KI), 6.0f * KI); l1[j] = fminf(fmaxf(l1[j], -8.0f * KI), 6.0f * KI);
                    d0[j] = __builtin_amdgcn_exp2f(g0[j]); d1[j] = __builtin_amdgcn_exp2f(g1[j]); }
                d0 = d0 + 1.0f; d1 = d1 + 1.0f; g0 = g0 * l0; g1 = g1 * l1;
#pragma unroll
                for (int j = 0; j < 4; ++j) { d0[j] = __builtin_amdgcn_rcpf(d0[j]); d1[j] = __builtin_amdgcn_rcpf(d1[j]); }
                o0 = g0 * d0; o1 = g1 * d1;
                *(u32x2*)(abase + alo + (unsigned)((ai * 128 + m * 16) * 16)) = (u32x2){pack4_fp8(o0[0], o0[1], o0[2], o0[3]), pack4_fp8(o1[0], o1[1], o1[2], o1[3])}; }
    }
};
__device__ __forceinline__ float pf_ld32(const float* base, const unsigned voff) { float v; asm volatile("global_load_dword %0, %1, %2" : "=v"(v) : "v"(voff), "s"(base) : "memory"); return v; }
struct EpiE2 {
    unsigned char* YS; const float* roww; const float* b2;
    static constexpr bool HAS_PF = true;
    __device__ __forceinline__ unsigned pf_off(const GUnit& u, const int tid) const { return (unsigned)(tid < 256 ? u.kind + tid : u.e * 1024 + u.pn * 256 + (tid - 256)) * 4u; }
    __device__ __forceinline__ float pf_load(const GUnit& u, const int tid, const int wid) const { return *(const float*)((const char*)(wid < 4 ? roww : b2) + pf_off(u, tid)); }
    __device__ __forceinline__ float pf_load_async(const GUnit& u, const int tid, const int wid) const { return pf_ld32(wid < 4 ? roww : b2, pf_off(u, tid)); }
    __device__ __forceinline__ void pf_wait(float& v) const { asm volatile("s_waitcnt vmcnt(8)" : "+v"(v) :: "memory"); }
    __device__ __forceinline__ void run(const Acc& acc, const GUnit& u, int wr, int wc, int fr, int fq, const LAS float* pf) const {
        const int row0 = u.pm * 256 + wr * 64 + fr, cb = u.pn * 256 + wc * 64 + fq * 16;
        f32x4 bv[2][2];
#pragma unroll
        for (int bj = 0; bj < 2; ++bj) { bv[bj][0] = *(const LAS f32x4*)(pf + 256 + wc * 64 + fq * 16 + bj * 8); bv[bj][1] = *(const LAS f32x4*)(pf + 256 + wc * 64 + fq * 16 + bj * 8 + 4); }
        float wv[8];
#pragma unroll
        for (int i = 0; i < 8; ++i) wv[i] = pf[wr * 64 + fr + (i >> 2) * 128 + (i & 3) * 16];
#pragma unroll
        for (int ai = 0; ai < 2; ++ai)
#pragma unroll
            for (int m = 0; m < 4; ++m) { const int row = row0 + ai * 128 + m * 16; const float w = wv[ai * 4 + m]; u32x4 pk;
#pragma unroll
                for (int bj = 0; bj < 2; ++bj) { const f32x4 v0 = (acc[ai][bj][m][0] * W8INV + bv[bj][0]) * w, v1 = (acc[ai][bj][m][1] * W8INV + bv[bj][1]) * w;
                    pk[2 * bj] = pack4_fp8(v0[0], v0[1], v0[2], v0[3]); pk[2 * bj + 1] = pack4_fp8(v1[0], v1[1], v1[2], v1[3]); }
                *(u32x4*)(YS + (size_t)row * 1024 + cb) = pk; }
    }
};

struct SimpleSched {
    const char* A; const char* B; size_t strideA, strideB; int nM, nN, G, c;
    __device__ __forceinline__ bool next(int i, GUnit& u) const {
        const long L = (long)i * G + c; if (L >= (long)nM * nN) return false;
        int pm, pn; pg8::tile_order((int)L, nM, nN, pm, pn);
        u.pm = pm; u.pn = pn; u.kind = 0; u.e = 0; u.idx = nullptr; u.A = A + (size_t)pm * strideA; u.B = B + (size_t)pn * strideB; return true;
    }
};
struct OneUnitSched {
    SimpleSched S; int i0;
    __device__ __forceinline__ bool next(int i, GUnit& u) const { return i == 0 && S.next(i0, u); }
};
struct P1Sched {
    const char *XB, *WIN, *MEMN, *WXK, *WXV; int G, c;
    __device__ __forceinline__ bool next(int i, GUnit& u) const {
        long L = (long)i * G + c; constexpr size_t TS = 256 * 1024 * 2; u.e = 0; u.idx = nullptr;
        if (L < 1792) { int pm, pn; pg8::tile_order((int)L, 128, 14, pm, pn); u.pm = pm; u.pn = pn; u.A = XB + pm * TS; u.B = WIN + pn * TS;
            u.kind = pn < 2 ? K_Q : (pn < 4 ? K_K : (pn < 6 ? K_U : (pn < 10 ? K_GA : K_GS))); return true; }
        L -= 1792;
        if (L < 256) { u.pm = (int)(L >> 7); u.pn = (int)(L & 127); u.A = WIN + (size_t)(14 + u.pm) * TS; u.B = XB + u.pn * TS; u.kind = K_VT; return true; }
        L -= 256;
        if (G == 256) return false;
        if (L < 64) { u.pm = (int)(L >> 2); u.pn = (int)(L & 3); u.A = MEMN + u.pm * TS; u.B = WXK + u.pn * TS; u.kind = K_XK; return true; }
        L -= 64;
        if (L < 64) { u.pm = (int)(L >> 4); u.pn = (int)(L & 15); u.A = WXV + u.pm * TS; u.B = MEMN + u.pn * TS; u.kind = K_XVT; return true; }
        return false;
    }
};
struct CrossSched {
    const char *MEMN, *WXK, *WXV; int G, c;
    __device__ __forceinline__ bool next(int i, GUnit& u) const {
        if (G != 256 || i != 0 || c >= 128) return false;
        constexpr size_t TS = 256 * 1024 * 2; u.e = 0; u.idx = nullptr; int L = c;
        if (L < 64) { u.pm = L >> 2; u.pn = L & 3; u.A = MEMN + u.pm * TS; u.B = WXK + u.pn * TS; u.kind = K_XK; return true; }
        L -= 64; u.pm = L >> 4; u.pn = L & 15; u.A = WXV + u.pm * TS; u.B = MEMN + u.pn * TS; u.kind = K_XVT; return true;
    }
};
struct GluSched {
    SimpleSched S;
    __device__ __forceinline__ bool next(int i, GUnit& u) const {
        if (S.G != 256) return S.next(i, u);
        if (S.c < 128) { if (i != 0) return false; } else if (i >= 3) return false;
        SimpleSched T = S; T.G = 128; T.c = S.c & 127; return T.next(S.c < 128 ? 0 : i + 1, u);
    }
};
struct MoeSched {
    const char* A; const char* W; const int* rowtok; const LAS int* blk_e; int nblk, NTN, G, c; size_t wstride  ; bool gather;
    __device__ __forceinline__ bool next(int i, GUnit& u) const {
        const int nx = (G % 8 == 0) ? 8 : 1, x = c % nx, r = c / nx, Wx = G / nx;
        const int b0 = (nblk * x) / nx, b1 = (nblk * (x + 1)) / nx;
        const long L = (long)i * Wx + r; if (L >= (long)(b1 - b0) * NTN) return false;
        const int blk = b0 + (int)(L / NTN), pn = (int)(L % NTN), e = __builtin_amdgcn_readfirstlane(blk_e[blk]);
        const int rb = e * MOE_CAP + (blk - __builtin_amdgcn_readfirstlane(blk_e[720 + e])) * 256;
        u.pm = blk; u.pn = pn; u.kind = rb; u.e = e; u.idx = rowtok + rb;
        u.A = gather ? A : A + (size_t)blk * 256 * 1024; u.B = W + (size_t)e * wstride + (size_t)pn * 256 * 1024; return true;
    }
};
#ifndef DA_PRIO_ON
#define DA_PRIO_ON 0
#endif
#if DA_PRIO_ON
#define DA_PRIO(x) __builtin_amdgcn_s_setprio(x)
#else
#define DA_PRIO(x) do { } while (0)
#endif
#define KSWZ(row, colB) ((row) * 256 + ((colB) ^ (((row) & 7) << 4)))
__device__ __forceinline__ int crow(int r, int hi) { return (r & 3) + 8 * (r >> 2) + 4 * hi; }
#define PK4(P, BASE, OUT) do { unsigned a0 = cvt_pk_bf16(P[BASE + 0], P[BASE + 1]), a1 = cvt_pk_bf16(P[BASE + 2], P[BASE + 3]);   \
    unsigned b0 = cvt_pk_bf16(P[BASE + 4], P[BASE + 5]), b1 = cvt_pk_bf16(P[BASE + 6], P[BASE + 7]);                              \
    auto r0 = __builtin_amdgcn_permlane32_swap(a0, b0, false, false); auto r1 = __builtin_amdgcn_permlane32_swap(a1, b1, false, false); \
    u32x4 w = {r0[0], r1[0], r0[1], r1[1]}; OUT = *reinterpret_cast<bf16x8*>(&w); } while (0)
__device__ __forceinline__ float half_max(float v) { auto rr = __builtin_amdgcn_permlane32_swap(__float_as_uint(v), __float_as_uint(v), false, false); return fmaxf(__uint_as_float(rr[0]), __uint_as_float(rr[1])); }
__device__ __forceinline__ float half_sum(float v) { auto rr = __builtin_amdgcn_permlane32_swap(__float_as_uint(v), __float_as_uint(v), false, false); return __uint_as_float(rr[0]) + __uint_as_float(rr[1]); }

constexpr int DA_NB = 4, DA_KT = 16384, DA_VT = 128 * 144, DA_K0 = 0, DA_V0 = DA_NB * DA_KT, DA_SCR = DA_V0 + DA_NB * DA_VT, DA_XCH = 0;
static_assert(DA_SCR + 8 * 256 <= PHASE_LDS && DA_XCH + 4 * 16384 <= DA_SCR, "diff-attn LDS");
constexpr float DA_THR = 11.5f;
__device__ __forceinline__ void da_partialSM(f32x16& p0, f32x16& p1, float& m_reg, float& alpha) {
    float pmax = p0[0];
#pragma unroll
    for (int r = 1; r < 16; ++r) pmax = fmaxf(pmax, p0[r]);
#pragma unroll
    for (int r = 0; r < 16; ++r) pmax = fmaxf(pmax, p1[r]);
    pmax = half_max(pmax);
    float mn;
    if (__builtin_expect(__all(pmax - m_reg <= DA_THR), 1)) { mn = m_reg; alpha = 1.f; }
    else { mn = fmaxf(m_reg, pmax); alpha = __builtin_amdgcn_exp2f(m_reg - mn); m_reg = mn; }
#pragma unroll
    for (int r = 0; r < 16; ++r) { p0[r] -= mn; p1[r] -= mn; }
#pragma unroll
    for (int r = 0; r < 16; ++r) p0[r] = __builtin_amdgcn_exp2f(p0[r]);
}
__device__ __forceinline__ void da_finishSM(f32x16& p0, f32x16& p1, const float alpha, float& l_reg, bf16x8& pa0, bf16x8& pa1, bf16x8& pa2, bf16x8& pa3) {
#pragma unroll
    for (int r = 0; r < 16; ++r) p1[r] = __builtin_amdgcn_exp2f(p1[r]);
    float ps = 0.f;
#pragma unroll
    for (int r = 0; r < 16; ++r) ps += p0[r];
#pragma unroll
    for (int r = 0; r < 16; ++r) ps += p1[r];
    ps = half_sum(ps);
    l_reg = l_reg * alpha + ps;
    PK4(p0, 0, pa0); PK4(p0, 8, pa1); PK4(p1, 0, pa2); PK4(p1, 8, pa3);
}
__device__ __forceinline__ void da_qkt(f32x16& p0, f32x16& p1, const LAS unsigned char* Ks, const bf16x8* qr, const int comp, const int r32, const int hi) {
#pragma unroll
    for (int r = 0; r < 16; ++r) { p0[r] = 0.f; p1[r] = 0.f; }
#pragma unroll
    for (int d0 = 0; d0 < 4; ++d0) { const int cb = (comp * 64 + d0 * 16 + hi * 8) * 2;
        const bf16x8 k0 = *(const LAS bf16x8*)(Ks + KSWZ(r32, cb)), k1 = *(const LAS bf16x8*)(Ks + KSWZ(32 + r32, cb));
        DA_PRIO(1);
        p0 = __builtin_amdgcn_mfma_f32_32x32x16_bf16(k0, qr[d0], p0, 0, 0, 0);
        p1 = __builtin_amdgcn_mfma_f32_32x32x16_bf16(k1, qr[d0], p1, 0, 0, 0);
        DA_PRIO(0); }
}
__device__ __forceinline__ void da_pv(f32x16* o, const LAS unsigned char* Vs, const bf16x8 pa0, const bf16x8 pa1, const bf16x8 pa2, const bf16x8 pa3, const int r32, const int hi) {
#pragma unroll
    for (int d0 = 0; d0 < 4; ++d0) { const LAS unsigned char* vp = Vs + (d0 * 32 + r32) * 144 + hi * 16;
        const bf16x8 v0 = *(const LAS bf16x8*)(vp), v1 = *(const LAS bf16x8*)(vp + 32), v2 = *(const LAS bf16x8*)(vp + 64), v3 = *(const LAS bf16x8*)(vp + 96);
        asm volatile("s_waitcnt lgkmcnt(0)" ::: "memory"); __builtin_amdgcn_sched_barrier(0);
        DA_PRIO(1);
        o[d0] = __builtin_amdgcn_mfma_f32_32x32x16_bf16(pa0, v0, o[d0], 0, 0, 0);
        o[d0] = __builtin_amdgcn_mfma_f32_32x32x16_bf16(pa1, v1, o[d0], 0, 0, 0);
        o[d0] = __builtin_amdgcn_mfma_f32_32x32x16_bf16(pa2, v2, o[d0], 0, 0, 0);
        o[d0] = __builtin_amdgcn_mfma_f32_32x32x16_bf16(pa3, v3, o[d0], 0, 0, 0);
        DA_PRIO(0); }
}
template <int VAR>
__device__ __forceinline__ void diff_attn_phase(LAS unsigned char* lds, const bf16_t* __restrict__ Q, const bf16_t* __restrict__ Kb, const bf16_t* __restrict__ VT, bf16_t* OAS,
                                                const float* subln_g, const float lam, const int G, const int c, const int wid) {
    const int lane = fresh_lane(), tid = wid * 64 + lane, r32 = lane & 31, hi = lane >> 5, comp = wid >> 2, w4 = wid & 3;
    LAS float* scr = (LAS float*)(lds + DA_SCR + wid * 256);
    constexpr int NT = SEQ / 64;
#define SBAR() __builtin_amdgcn_sched_barrier(0)
    for (int L = c; L < NBATCH * 4 * 16; L += G) {
        const int bh = L >> 4, qb = L & 15, b = bh >> 2, h = bh & 3;
        const size_t tok0 = (size_t)b * SEQ;
        bf16x8 qr[4];
        { const bf16_t* qp = Q + (tok0 + qb * 128 + w4 * 32 + r32) * 512 + h * 128 + comp * 64 + hi * 8;
#pragma unroll
          for (int d0 = 0; d0 < 4; ++d0) qr[d0] = *(const GAS bf16x8*)(qp + d0 * 16); }
        const bf16_t* kg = Kb + (tok0 + (tid >> 4)) * 512 + h * 128 + (tid & 15) * 8;
        const bf16_t* vg = VT + (size_t)(h * 128 + (tid >> 3)) * NTOK + tok0 + (tid & 7) * 8;
        const int kl0 = KSWZ((tid >> 4), (tid & 15) * 16), kl1 = KSWZ(32 + (tid >> 4), (tid & 15) * 16), vl0 = (tid >> 3) * 144 + (tid & 7) * 16, vl1 = vl0 + 64 * 144;
        bf16x8 ek0, ek1, ev0, ev1, fk0, fk1, fv0, fv1;
#define DA_LOAD(k0_, k1_, v0_, v1_, j) do { k0_ = *(const GAS bf16x8*)(kg + (size_t)(j) * 64 * 512); k1_ = *(const GAS bf16x8*)(kg + (size_t)((j) * 64 + 32) * 512); \
                        v0_ = *(const GAS bf16x8*)(vg + (j) * 64); v1_ = *(const GAS bf16x8*)(vg + (size_t)64 * NTOK + (j) * 64); } while (0)
#define DA_WRITE(bf, k0_, k1_, v0_, v1_) do { *(LAS bf16x8*)(lds + DA_K0 + (bf) * DA_KT + kl0) = k0_; *(LAS bf16x8*)(lds + DA_K0 + (bf) * DA_KT + kl1) = k1_; \
                          *(LAS bf16x8*)(lds + DA_V0 + (bf) * DA_VT + vl0) = v0_; *(LAS bf16x8*)(lds + DA_V0 + (bf) * DA_VT + vl1) = v1_; } while (0)
#define DA_SWAIT() asm volatile("s_waitcnt vmcnt(4)" ::: "memory")
#define DA_SYNC() do { if (VAR != 3) __syncthreads(); } while (0)
#define DA_RESC(a) do { if (__any((a) < 1.f)) { if (hi == 0) scr[r32] = (a); LDS_WAIT(); \
            _Pragma("unroll") for (int r = 0; r < 16; ++r) { const float a_ = scr[crow(r, hi)]; _Pragma("unroll") for (int d = 0; d < 4; ++d) o[d][r] *= a_; } } } while (0)
        float m_reg = -1e30f, l_reg = 0.f, al; f32x16 o[4], p0, p1; bf16x8 pa0, pa1, pa2, pa3;
#pragma unroll
        for (int d = 0; d < 4; ++d)
#pragma unroll
            for (int r = 0; r < 16; ++r) o[d][r] = 0.f;
#define DA_BAR() do { asm volatile("s_waitcnt lgkmcnt(0)" ::: "memory"); __builtin_amdgcn_s_barrier(); } while (0)
#define DA_KB(b) (lds + DA_K0 + (b) * DA_KT)
#define DA_VB(b) (lds + DA_V0 + (b) * DA_VT)
        DA_LOAD(ek0, ek1, ev0, ev1, 0); VM_WAIT(); DA_WRITE(0, ek0, ek1, ev0, ev1);
        DA_LOAD(ek0, ek1, ev0, ev1, 1); VM_WAIT(); DA_WRITE(1, ek0, ek1, ev0, ev1);
        DA_LOAD(ek0, ek1, ev0, ev1, 2);
        DA_BAR();
        if (comp == 1) DA_BAR();
#pragma unroll 1
        for (int t = 0; t < NT; t += 4) {
#pragma unroll
            for (int k = 0; k < 4; ++k) { const int u = t + k;
                SBAR(); da_qkt(p0, p1, DA_KB(k), qr, comp, r32, hi); da_partialSM(p0, p1, m_reg, al); SBAR();
                DA_BAR();
                da_finishSM(p0, p1, al, l_reg, pa0, pa1, pa2, pa3); DA_RESC(al); SBAR();
                if (u + 2 < NT) { VM_WAIT(); DA_WRITE((k + 2) & 3, ek0, ek1, ev0, ev1); }
                if (u + 3 < NT) DA_LOAD(ek0, ek1, ev0, ev1, u + 3);
                SBAR(); da_pv(o, DA_VB(k), pa0, pa1, pa2, pa3, r32, hi); SBAR();
                DA_BAR();
            }
        }
        if (comp == 0) DA_BAR();
#undef DA_BAR
#undef DA_KB
#undef DA_VB
        __syncthreads();
        if (hi == 0) scr[r32] = __builtin_amdgcn_rcpf(l_reg);
        LDS_WAIT();
#pragma unroll
        for (int r = 0; r < 16; ++r) { const float a = scr[crow(r, hi)];
#pragma unroll
            for (int d = 0; d < 4; ++d) o[d][r] *= a; }
        LAS float* xch = (LAS float*)(lds + DA_XCH + w4 * 16384);
        if (comp == 1) {
#pragma unroll
            for (int d = 0; d < 4; ++d)
#pragma unroll
                for (int r = 0; r < 16; ++r) xch[(d * 16 + r) * 64 + lane] = o[d][r];
        }
        __syncthreads();
        if (comp == 0) {
            float ssq[16];
#pragma unroll
            for (int r = 0; r < 16; ++r) ssq[r] = 0.f;
#pragma unroll
            for (int d = 0; d < 4; ++d)
#pragma unroll
                for (int r = 0; r < 16; ++r) { const float v = o[d][r] - lam * xch[(d * 16 + r) * 64 + lane]; o[d][r] = v; ssq[r] += v * v; }
#pragma unroll
            for (int r = 0; r < 16; ++r) {
                float s = ssq[r];
                s += __shfl_xor(s, 1); s += __shfl_xor(s, 2); s += __shfl_xor(s, 4); s += __shfl_xor(s, 8); s += __shfl_xor(s, 16);
                ssq[r] = __builtin_amdgcn_rsqf(s * (1.0f / 128.0f) + EPS) * (1.0f - LAMBDA_INIT);
            }
            const int lnb = fresh_lane(), r32b = lnb & 31, hib = lnb >> 5;
            bf16_t* op = OAS + (tok0 + qb * 128 + w4 * 32) * 1024 + h * 128 + r32b;
#pragma unroll
            for (int d = 0; d < 4; ++d) { const float g = subln_g[d * 32 + r32b];
#pragma unroll
                for (int r = 0; r < 16; ++r) { const float v = o[d][r] * ssq[r] * g; op[(size_t)crow(r, hib) * 1024 + d * 32] = (bf16_t)(cvt_pk_bf16(v, 0.f) & 0xffffu); } }
        }
        __syncthreads();
#undef DA_LOAD
#undef DA_WRITE
#undef DA_SWAIT
#undef DA_SYNC
#undef DA_RESC
    }
#undef SBAR
}

#define XSWZ(row, chunk) ((row) * 528 + (chunk) * 16)
constexpr int XA_BYTES = 256 * 528;
__device__ __forceinline__ void cross_attn_unit(LAS unsigned char* lds, const bf16_t* __restrict__ XQ, const bf16_t* __restrict__ XK, const bf16_t* __restrict__ XVT, bf16_t* XO, const int b, const int h, const int qb, const int wid) {
    const int lane = fresh_lane(), tid = wid * 64 + lane, r32 = lane & 31, hi = lane >> 5;
    LAS float* scr = (LAS float*)(lds + XA_BYTES + wid * 256);
    {
        { const bf16_t* src = XK + ((size_t)b * NMEM + (tid >> 5)) * 1024 + h * 256 + (tid & 31) * 8; LAS unsigned char* dst = lds + XSWZ(tid >> 5, tid & 31);
#pragma unroll 1
          for (int i0 = 0; i0 < 16; i0 += 8) { bf16x8 t[8];
#pragma unroll
            for (int i = 0; i < 8; ++i) t[i] = *(const bf16x8*)(src + (size_t)(i0 + i) * 16 * 1024);
#pragma unroll
            for (int i = 0; i < 8; ++i) *(LAS bf16x8*)(dst + (i0 + i) * 16 * 528) = t[i]; } }
        const bf16_t* qp = XQ + ((size_t)b * SEQ + qb * 256 + wid * 32 + r32) * 1024 + h * 256 + hi * 8;
        bf16x8 pa[16]; float linv;
        {
            f32x16 s[8];
#pragma unroll
            for (int kb = 0; kb < 8; ++kb)
#pragma unroll
                for (int r = 0; r < 16; ++r) s[kb][r] = 0.f;
            bf16x8 qa[2], qn[2];
#pragma unroll
            for (int i = 0; i < 2; ++i) qa[i] = *(const bf16x8*)(qp + i * 16);
            __syncthreads();
#pragma unroll
            for (int dg = 0; dg < 8; ++dg) {
                if (dg < 7) {
#pragma unroll
                    for (int i = 0; i < 2; ++i) qn[i] = *(const bf16x8*)(qp + (dg * 2 + 2 + i) * 16);
                }
                __builtin_amdgcn_sched_barrier(0);
#pragma unroll
                for (int i = 0; i < 2; ++i) { const int d0 = dg * 2 + i;
#pragma unroll
                    for (int kb = 0; kb < 8; ++kb) { const bf16x8 kf = *(const LAS bf16x8*)(lds + XSWZ(kb * 32 + r32, d0 * 2 + hi));
                        s[kb] = __builtin_amdgcn_mfma_f32_32x32x16_bf16(kf, qa[i], s[kb], 0, 0, 0); } }
                __builtin_amdgcn_sched_barrier(0);
#pragma unroll
                for (int i = 0; i < 2; ++i) qa[i] = qn[i];
            }
            float mx = s[0][0];
#pragma unroll
            for (int kb = 0; kb < 8; ++kb)
#pragma unroll
                for (int r = 0; r < 16; ++r) mx = fmaxf(mx, s[kb][r]);
            mx = half_max(mx);
            float ps = 0.f;
#pragma unroll
            for (int kb = 0; kb < 8; ++kb)
#pragma unroll
                for (int r = 0; r < 16; ++r) { s[kb][r] = __builtin_amdgcn_exp2f(s[kb][r] - mx); ps += s[kb][r]; }
            ps = half_sum(ps); linv = __builtin_amdgcn_rcpf(ps);
#pragma unroll
            for (int kb = 0; kb < 8; ++kb) { PK4(s[kb], 0, pa[2 * kb]); PK4(s[kb], 8, pa[2 * kb + 1]); }
        }
        __syncthreads();
        { const bf16_t* src = XVT + ((size_t)h * 256 + (tid >> 5)) * NMEMTOK + b * NMEM + (tid & 31) * 8; LAS unsigned char* dst = lds + XSWZ(tid >> 5, tid & 31);
#pragma unroll 1
          for (int i0 = 0; i0 < 16; i0 += 8) { bf16x8 t[8];
#pragma unroll
            for (int i = 0; i < 8; ++i) t[i] = *(const bf16x8*)(src + (size_t)(i0 + i) * 16 * NMEMTOK);
#pragma unroll
            for (int i = 0; i < 8; ++i) *(LAS bf16x8*)(dst + (i0 + i) * 16 * 528) = t[i]; } }
        if (hi == 0) scr[r32] = linv;
        __syncthreads();
        bf16_t* op = XO + ((size_t)b * SEQ + qb * 256 + wid * 32) * 1024 + h * 256 + r32;
#pragma unroll
        for (int cb = 0; cb < 8; ++cb) {
            f32x16 o;
#pragma unroll
            for (int r = 0; r < 16; ++r) o[r] = 0.f;
#pragma unroll
            for (int ks = 0; ks < 16; ++ks) { const bf16x8 vf = *(const LAS bf16x8*)(lds + XSWZ(cb * 32 + r32, ks * 2 + hi));
                o = __builtin_amdgcn_mfma_f32_32x32x16_bf16(pa[ks], vf, o, 0, 0, 0); }
#pragma unroll
            for (int r = 0; r < 16; ++r) { const float v = o[r] * scr[crow(r, hi)]; op[(size_t)crow(r, hi) * 1024 + cb * 32] = (bf16_t)(cvt_pk_bf16(v, 0.f) & 0xffffu); }
        }
        __syncthreads();
    }
}
constexpr int TP_PITCH = 136;
template <bool HAS_GAIN, class RowMap>
__device__ __forceinline__ void transpose_item(const float* __restrict__ W, const int K, const int N, bf16_t* WT, const float* gain, const RowMap& drow, LAS unsigned char* scr, const int item, const int lane, const int pitch = 0) {
    const int nblk = N / 64, kb = item / nblk, nb = item % nblk, k0 = kb * 64, n0 = nb * 64;
    const int nl = (lane & 15) * 4, kq = lane >> 4;
#pragma unroll
    for (int p = 0; p < 8; ++p) { const int kk = p * 8 + kq * 2;
        f32x4 a = *(const f32x4*)(W + (size_t)(k0 + kk) * N + n0 + nl), b = *(const f32x4*)(W + (size_t)(k0 + kk + 1) * N + n0 + nl);
        if (HAS_GAIN) { const float g0 = gain[k0 + kk], g1 = gain[k0 + kk + 1]; a = a * g0; b = b * g1; }
#pragma unroll
        for (int j = 0; j < 4; ++j) *(LAS unsigned*)(scr + (nl + j) * TP_PITCH + kk * 2) = cvt_pk_bf16(a[j], b[j]); }
    LDS_WAIT();
#pragma unroll
    for (int q = 0; q < 8; ++q) { const int n = q * 8 + (lane >> 3), ch = lane & 7;
        const u32x2 lo = *(const LAS u32x2*)(scr + n * TP_PITCH + ch * 16), hi = *(const LAS u32x2*)(scr + n * TP_PITCH + ch * 16 + 8);
        const int dr = drow(n0 + (n & ~7)) + (n & 7);
        *(u32x4*)(WT + (size_t)dr * (pitch ? pitch : K) + k0 + ch * 8) = (u32x4){lo.x, lo.y, hi.x, hi.y}; }
    LDS_WAIT();
}
template <class RowMap>
__device__ __forceinline__ void transpose_item_f8(const float* __restrict__ W, const int K, const int N, unsigned char* WT, const float* gain, const float scale, const RowMap& drow, LAS unsigned char* scr, const int item, const int lane) {
    const int nblk = N / 64, kb = item / nblk, nb = item % nblk, k0 = kb * 64, n0 = nb * 64;
    const int nl = (lane & 15) * 4, kq = lane >> 4;
#pragma unroll
    for (int p = 0; p < 4; ++p) { const int kk = p * 16 + kq * 4; f32x4 a[4];
#pragma unroll
        for (int r = 0; r < 4; ++r) { a[r] = *(const f32x4*)(W + (size_t)(k0 + kk + r) * N + n0 + nl); a[r] = a[r] * ((gain ? gain[k0 + kk + r] : 1.0f) * scale); }
#pragma unroll
        for (int j = 0; j < 4; ++j) *(LAS unsigned*)(scr + (nl + j) * 80 + kk) = pack4_fp8(a[0][j], a[1][j], a[2][j], a[3][j]); }
    LDS_WAIT();
#pragma unroll
    for (int q = 0; q < 4; ++q) { const int n = q * 16 + (lane >> 2), ch = lane & 3;
        const u32x4 v = *(const LAS u32x4*)(scr + n * 80 + ch * 16);
        const int dr = drow(n0 + (n & 32)) + (n & 31);
        *(u32x4*)(WT + (size_t)dr * K + k0 + ch * 16) = v; }
    LDS_WAIT();
}
struct ExpItem { const float* W; unsigned char* WT; const float* gain; int K, N, k0, n0, doff, is_e1; };
__device__ __forceinline__ ExpItem exp_item(const int it, const float* we1, const float* we2, const float* gffn, unsigned char* ws) {
    ExpItem x;
    if (it < 32 * 512) { const int e = it >> 9, r = it & 511; x.W = we1 + (size_t)e * 1024 * 2048; x.WT = ws + WS_WE1; x.gain = gffn; x.K = 1024; x.N = 2048; x.k0 = (r >> 6) * 128; x.n0 = (r & 63) * 32; x.doff = e * 2048; x.is_e1 = 1; }
    else { const int q = it - 32 * 512, e = q >> 8, r = q & 255; x.W = we2 + (size_t)e * 1024 * 1024; x.WT = ws + WS_WE2; x.gain = nullptr; x.K = 1024; x.N = 1024; x.k0 = (r >> 5) * 128; x.n0 = (r & 31) * 32; x.doff = e * 1024; x.is_e1 = 0; }
    return x;
}
__device__ __forceinline__ void exp_load(const ExpItem& x, f32x4 (&a)[4][4], const int lane) {
    const unsigned lane_off = (unsigned)(((lane >> 3) * 4 * x.N + (lane & 7) * 4) * 4);
#pragma unroll
    for (int p = 0; p < 4; ++p)
#pragma unroll
        for (int r = 0; r < 4; ++r) { const char* rowp = (const char*)(x.W + (size_t)(x.k0 + p * 32 + r) * x.N + x.n0); a[p][r] = *(const f32x4*)(rowp + lane_off); }
}
template <bool E1>
__device__ __forceinline__ void exp_store(const ExpItem& x, f32x4 (&a)[4][4], LAS unsigned char* scr, const int lane) {
    const int nl = (lane & 7) * 4, kq = lane >> 3;
#pragma unroll
    for (int p = 0; p < 4; ++p) { const int kk = p * 32 + kq * 4;
#pragma unroll
        for (int r = 0; r < 4; ++r) a[p][r] = a[p][r] * ((E1 ? x.gain[x.k0 + kk + r] : 1.0f) * W8SCALE);
#pragma unroll
        for (int j = 0; j < 4; ++j) *(LAS unsigned*)(scr + (nl + j) * 144 + kk) = pack4_fp8(a[p][0][j], a[p][1][j], a[p][2][j], a[p][3][j]); }
    LDS_WAIT();
#pragma unroll
    for (int q = 0; q < 4; ++q) { const int n = q * 8 + (lane >> 3), ch = lane & 7;
        const u32x4 v = *(const LAS u32x4*)(scr + n * 144 + ch * 16);
        const int ns = x.n0 + n; int dr;
        if (E1) { const int bj = ns >> 10, rr = ns & 1023; dr = x.doff + (rr >> 7) * 256 + bj * 128 + (rr & 127); } else dr = x.doff + ns;
        *(u32x4*)(x.WT + (size_t)dr * x.K + x.k0 + ch * 16) = v; }
    LDS_WAIT();
}
__device__ __forceinline__ int opaque_s(int v) { asm volatile("" : "+s"(v)); return v; }
template <bool E1>
__device__ __forceinline__ void expert_convert(const float* we1, const float* we2, const float* gffn, unsigned char* ws, LAS unsigned char* scr, const int lo, const int hi, const int gw, const int NGW, const int lane) {
    f32x4 A[4][4], B[4][4];
    int it = lo + gw;
    if (it < hi) exp_load(exp_item(opaque_s(it), we1, we2, gffn, ws), A, lane);
    for (; it < hi; it += 2 * NGW) { const int it1 = it + NGW, it2 = it1 + NGW;
        if (it1 < hi) exp_load(exp_item(opaque_s(it1), we1, we2, gffn, ws), B, lane);
        exp_store<E1>(exp_item(opaque_s(it), we1, we2, gffn, ws), A, scr, lane);
        if (it1 < hi) { if (it2 < hi) exp_load(exp_item(opaque_s(it2), we1, we2, gffn, ws), A, lane);
            exp_store<E1>(exp_item(opaque_s(it1), we1, we2, gffn, ws), B, scr, lane); } }
}
struct MapIdent { int off; __device__ __forceinline__ int operator()(int n) const { return off + n; } };
struct MapWin {
    __device__ __forceinline__ int operator()(int n) const {
        if (n < 1024) { const int blk = n >> 9, r = n & 511, tile = r >> 8, w = (r & 255) >> 6, half = (r & 63) >> 5, i = r & 31; return blk * 512 + tile * 256 + w * 64 + (i >> 3) * 16 + half * 8; }
        if (n < 1536) return 3584 + (n - 1024);
        return n - 512;
    }
};
struct MapGlu { __device__ __forceinline__ int operator()(int n) const { const int bj = n >> 9, r = n & 511; return (r >> 7) * 256 + bj * 128 + (r & 127); } };
struct MapE1 { int off; __device__ __forceinline__ int operator()(int n) const { const int bj = n >> 10, r = n & 1023; return off + (r >> 7) * 256 + bj * 128 + (r & 127); } };

struct Params {
    const float* in[34]; float* out; unsigned char* ws; int ph_lo, ph_hi;
};
enum { I_X = 0, I_MEM, I_NMIXG, I_WIN, I_LQ1, I_LK1, I_LQ2, I_LK2, I_SUBLN, I_ARE, I_AIM, I_LOGDT, I_BRE, I_BIM, I_CRE, I_CIM, I_SSMD, I_WGLU, I_WBA, I_WBS, I_WMIX, I_NCROSSG, I_NMEMG,
       I_WXQ, I_WXKV, I_WXO, I_NFFNG, I_WROUTER, I_BROUTER, I_WE1, I_BE1, I_WE2, I_BE2, I_NFING };

typedef const Params __attribute__((address_space(4)))* KParams;
__device__ __forceinline__ void prologue_phase(LAS unsigned char* lds, KParams Pk, unsigned char* ws, const int G, const int c, const int wid) {
    const int lane = fresh_lane(), tid = wid * 64 + lane;
    const int gw = c * 8 + wid, NGW = G * 8;
    LAS unsigned char* scr = lds + wid * 16384;
    constexpr int IT_WIN = 16 * 64, IT_GLU = 8 * 16, IT_BA = 8 * 16, IT_MIX = 16 * 16, IT_XQ = 256, IT_XKV = 16 * 32, IT_XO = 256, IT_E1 = 16 * 32, IT_E2 = 16 * 16;
    constexpr int NIT = IT_WIN + IT_GLU + 2 * IT_BA + IT_MIX + IT_XQ + IT_XKV + IT_XO;
    for (int it = gw; it < NIT; it += NGW) {
        int r = it;
        if (r < IT_WIN) { transpose_item<true>(Pk->in[I_WIN], 1024, 4096, (bf16_t*)(ws + WS_WIN), Pk->in[I_NMIXG], MapWin{}, scr, r, lane); continue; } r -= IT_WIN;
        if (r < IT_GLU) { transpose_item<false>(Pk->in[I_WGLU], 512, 1024, (bf16_t*)(ws + WS_WGLU), nullptr, MapGlu{}, scr, r, lane); continue; } r -= IT_GLU;
        if (r < IT_BA) { transpose_item<false>(Pk->in[I_WBA], 512, 1024, (bf16_t*)(ws + WS_WBA), nullptr, MapIdent{0}, scr, r, lane, 1024); continue; } r -= IT_BA;
        if (r < IT_BA) { transpose_item<false>(Pk->in[I_WBS], 512, 1024, (bf16_t*)(ws + WS_WBA) + 512, nullptr, MapIdent{0}, scr, r, lane, 1024); continue; } r -= IT_BA;
        if (r < IT_MIX) { transpose_item<false>(Pk->in[I_WMIX], 1024, 1024, (bf16_t*)(ws + WS_WMIX), nullptr, MapIdent{0}, scr, r, lane); continue; } r -= IT_MIX;
        if (r < IT_XQ) { transpose_item<true>(Pk->in[I_WXQ], 1024, 1024, (bf16_t*)(ws + WS_WXQ), Pk->in[I_NCROSSG], MapIdent{0}, scr, r, lane); continue; } r -= IT_XQ;
        if (r < IT_XKV) { transpose_item<false>(Pk->in[I_WXKV], 1024, 2048, (bf16_t*)(ws + WS_WXK), nullptr, MapIdent{0}, scr, r, lane); continue; } r -= IT_XKV;
        transpose_item<false>(Pk->in[I_WXO], 1024, 1024, (bf16_t*)(ws + WS_WXO), nullptr, MapIdent{0}, scr, r, lane);
    }
    { bf16_t* XB = (bf16_t*)(ws + WS_XB); float* rstd0 = (float*)(ws + WS_RSTD0); const float* x = Pk->in[I_X];
      for (int m = gw; m < NTOK; m += NGW) { f32x4 v[4]; float s = 0.f;
#pragma unroll
          for (int q = 0; q < 4; ++q) { v[q] = *(const f32x4*)(x + (size_t)m * 1024 + q * 256 + lane * 4); s += (v[q][0] * v[q][0] + v[q][1] * v[q][1]) + (v[q][2] * v[q][2] + v[q][3] * v[q][3]); }
          s = wave_sum(s);
#pragma unroll
          for (int q = 0; q < 4; ++q) *(u32x2*)(XB + (size_t)m * 1024 + q * 256 + lane * 4) = (u32x2){cvt_pk_bf16(v[q][0], v[q][1]), cvt_pk_bf16(v[q][2], v[q][3])};
          if (lane == 0) rstd0[m] = __builtin_amdgcn_rsqf(s * (1.0f / DM) + EPS); } }
    { bf16_t* MN = (bf16_t*)(ws + WS_MEMN); const float* mem = Pk->in[I_MEM]; const float* gm = Pk->in[I_NMEMG];
      for (int m = gw; m < NMEMTOK; m += NGW) { f32x4 v[4]; float s = 0.f;
#pragma unroll
          for (int q = 0; q < 4; ++q) { v[q] = *(const f32x4*)(mem + (size_t)m * 1024 + q * 256 + lane * 4); s += (v[q][0] * v[q][0] + v[q][1] * v[q][1]) + (v[q][2] * v[q][2] + v[q][3] * v[q][3]); }
          const float rs = __builtin_amdgcn_rsqf(wave_sum(s) * (1.0f / DM) + EPS);
#pragma unroll
          for (int q = 0; q < 4; ++q) { const f32x4 g = *(const f32x4*)(gm + q * 256 + lane * 4); const f32x4 o = v[q] * rs * g;
              *(u32x2*)(MN + (size_t)m * 1024 + q * 256 + lane * 4) = (u32x2){cvt_pk_bf16(o[0], o[1]), cvt_pk_bf16(o[2], o[3])}; } } }
    const int gt = c * 512 + tid, NGT = G * 512;
    { float* rope = (float*)(ws + WS_ROPE);
      for (int i = gt; i < SEQ * 32; i += NGT) { const int pos = i >> 5, f = i & 31; const float inv = exp2f(-(float)f * (13.287712379549449f / 32.0f)); float sn, cs; sincosf((float)pos * inv, &sn, &cs); rope[2 * i] = cs; rope[2 * i + 1] = sn; } }
    {
      float* AB = (float*)(ws + WS_S5AB); bf16_t* BB = (bf16_t*)(ws + WS_S5BB); bf16_t* CC = (bf16_t*)(ws + WS_S5CC);
      for (int i2 = gt; i2 < 2 * 32 * 64 * 16; i2 += NGT) { const int h = i2 & 15, i = i2 >> 4, dg = i >> 6, p = i & 63;
          const float are = Pk->in[I_ARE][i], aim = Pk->in[I_AIM][i], dt = expf(Pk->in[I_LOGDT][dg]);
          const float mag = expf(are * dt), ang = aim * dt; float sn, cs; sincosf(ang, &sn, &cs);
          const float abr = mag * cs, abi = mag * sn, den = are * are + aim * aim, nr = abr - 1.0f;
          const float cre = (nr * are + abi * aim) / den, cim = (abi * are - nr * aim) / den;
          if (h == 0) { AB[2 * i] = abr; AB[2 * i + 1] = abi; }
          const float br = Pk->in[I_BRE][(size_t)i * 16 + h], bi = Pk->in[I_BIM][(size_t)i * 16 + h];
          BB[((size_t)dg * 128 + 2 * p) * 16 + h] = (bf16_t)(cvt_pk_bf16(cre * br - cim * bi, 0.f) & 0xffffu);
          BB[((size_t)dg * 128 + 2 * p + 1) * 16 + h] = (bf16_t)(cvt_pk_bf16(cre * bi + cim * br, 0.f) & 0xffffu);
          const float crv = Pk->in[I_CRE][(size_t)dg * 16 * 64 + h * 64 + p], civ = Pk->in[I_CIM][(size_t)dg * 16 * 64 + h * 64 + p];
          CC[((size_t)dg * 16 + h) * 128 + 2 * p] = (bf16_t)(cvt_pk_bf16(crv, 0.f) & 0xffffu);
          CC[((size_t)dg * 16 + h) * 128 + 2 * p + 1] = (bf16_t)(cvt_pk_bf16(-civ, 0.f) & 0xffffu); } }
    {
      bf16_t* WR = (bf16_t*)(ws + WS_WR); const float* wrt = Pk->in[I_WROUTER]; const float* gf = Pk->in[I_NFFNG];
      for (int i = gt; i < 32 * 1024; i += NGT) { const int e = i >> 10, k = i & 1023; const float v = wrt[k * 32 + e] * gf[k]; const unsigned hb = cvt_pk_bf16(v, 0.f) & 0xffffu; const float lo = v - bf_lo(hb);
          const int pos = ((((k >> 5) * 4 + (e >> 4)) * 64 + ((k >> 3) & 3) * 16 + (e & 15)) << 3) + (k & 7);
          WR[pos] = (bf16_t)hb; WR[pos + 2 * 64 * 8] = (bf16_t)(cvt_pk_bf16(lo, 0.f) & 0xffffu); } }
    if (c == G - 1 && wid == 7) { const float s1 = wave_sum(Pk->in[I_LQ1][lane] * Pk->in[I_LK1][lane]), s2 = wave_sum(Pk->in[I_LQ2][lane] * Pk->in[I_LK2][lane]);
        if (lane == 0) *(float*)(ws + WS_LAM) = expf(s1) - expf(s2) + LAMBDA_INIT; }
}
constexpr int S5_T = 32, S5_NC = SEQ / S5_T, S5_BP = 132  , S5_BU = S5_T * S5_BP * 4, S5_XP = 272, S5_X = S5_T * S5_XP, S5_WAVE = S5_BU + S5_X;
static_assert(4 * S5_WAVE + 4 * 8192 <= PHASE_LDS, "S5 LDS");
__device__ __forceinline__ float gelu_tanh(float x) { const float z = 0.7978845608028654f * (x + 0.044715f * x * x * x); return x * __builtin_amdgcn_rcpf(1.0f + __builtin_amdgcn_exp2f(-2.0f * LOG2E * z)); }
template <int DIR>
__device__ __forceinline__ void s5_scan_wave(LAS unsigned char* lds, const bf16_t* U, float* YP, bf16_t* SG, const float* s5ab, const bf16_t* s5bb, const bf16_t* s5cc, const float* dskip, const int pair, const int wid, const int lane) {
    const int fr = lane & 15, fq = lane >> 4;
        const int dir = DIR, b = pair >> 5, g = pair & 31;
        LAS float* BU = (LAS float*)(lds + (wid & 3) * S5_WAVE); LAS unsigned char* XS = lds + (wid & 3) * S5_WAVE + S5_BU;
        bf16x8 bb[8], cc[4]; float ar, ai, nai, xr = 0.f, xi = 0.f, dsk;
        { const bf16_t* bp = s5bb + (size_t)(dir * 32 + g) * 128 * 16;
#pragma unroll
          for (int cb = 0; cb < 8; ++cb) { if (fq < 2) bb[cb] = *(const bf16x8*)(bp + (cb * 16 + fr) * 16 + fq * 8); else bb[cb] = (bf16x8){0, 0, 0, 0, 0, 0, 0, 0}; }
          const bf16_t* cp = s5cc + (size_t)(dir * 32 + g) * 16 * 128;
#pragma unroll
          for (int kb = 0; kb < 4; ++kb) cc[kb] = *(const bf16x8*)(cp + fr * 128 + kb * 32 + fq * 8);
          const float* ap = s5ab + ((size_t)(dir * 32 + g) * 64 + lane) * 2; ar = ap[0]; ai = ap[1]; nai = -ai;
          dsk = dskip[g * 16 + fr]; }
        const bf16x8 zero8 = (bf16x8){0, 0, 0, 0, 0, 0, 0, 0};
#define S5_TC(ci_) (dir ? (S5_NC - 1 - (ci_)) : (ci_))
#define S5_LOADU(ci_, A0, A1) do { const int l_ = fresh_lane(), fr = l_ & 15, fq = l_ >> 4; const size_t tk_ = (size_t)b * SEQ + S5_TC(ci_) * S5_T; const bf16_t* p0_ = U + (tk_ + fr) * 512 + g * 16 + (fq & 1) * 8; const bf16_t* p1_ = p0_ + 16 * 512; \
            asm volatile("global_load_dwordx4 %0, %1, off" : "=v"(A0) : "v"(p0_) : "memory"); asm volatile("global_load_dwordx4 %0, %1, off" : "=v"(A1) : "v"(p1_) : "memory"); } while (0)
#define S5_LOADPU(ci_) do { const int l_ = fresh_lane(), fr = l_ & 15, fq = l_ >> 4; const size_t tk_ = (size_t)b * SEQ + S5_TC(ci_) * S5_T; _Pragma("unroll") for (int q_ = 0; q_ < 8; ++q_) { const size_t off_ = (tk_ + (q_ >> 2) * 16 + fq * 4 + (q_ & 3)) * 512 + g * 16 + fr; const float* yp_ = YP + off_; const bf16_t* up_ = U + off_; \
            asm volatile("global_load_dword %0, %1, off sc1" : "=v"(pt[q_]) : "v"(yp_) : "memory"); asm volatile("global_load_ushort %0, %1, off" : "=v"(uv[q_]) : "v"(up_) : "memory"); } } while (0)
#define S5_TIE_U(A0, A1) asm volatile("" : "+v"(A0), "+v"(A1) :: "memory")
#define S5_TIE_PU() asm volatile("" : "+v"(pt[0]), "+v"(pt[1]), "+v"(pt[2]), "+v"(pt[3]), "+v"(pt[4]), "+v"(pt[5]), "+v"(pt[6]), "+v"(pt[7]), "+v"(uv[0]), "+v"(uv[1]), "+v"(uv[2]), "+v"(uv[3]), "+v"(uv[4]), "+v"(uv[5]), "+v"(uv[6]), "+v"(uv[7]) :: "memory")
#define S5_BUM(i, A0, A1) do { const bf16x8 ua_ = ((i) >> 3) ? A1 : A0; const f32x4 d_ = __builtin_amdgcn_mfma_f32_16x16x32_bf16(fq < 2 ? ua_ : zero8, bb[(i) & 7], (f32x4){0.f, 0.f, 0.f, 0.f}, 0, 0, 0); \
            _Pragma("unroll") for (int j_ = 0; j_ < 4; ++j_) BU[(((i) >> 3) * 16 + fq * 4 + j_) * S5_BP + ((i) & 7) * 16 + fr] = d_[j_]; } while (0)
#define S5_OUT(H, ci_) do { const int l_ = fresh_lane(), fr = l_ & 15, fq = l_ >> 4; const size_t tk_ = (size_t)b * SEQ + S5_TC(ci_) * S5_T; _Pragma("unroll") for (int rb_ = 0; rb_ < 2; ++rb_) { \
            if (H == 0) { float* d_ = YP + (tk_ + rb_ * 16 + fq * 4 + 2) * 512 + g * 16 + fr; \
                asm volatile("s_nop 7\n\ts_nop 7\n\ts_nop 4\n\tglobal_store_dword %0, %1, off offset:-4096\n\tglobal_store_dword %0, %2, off offset:-2048\n\tglobal_store_dword %0, %3, off\n\tglobal_store_dword %0, %4, off offset:2048" \
                             :: "v"(d_), "v"(yv[rb_][0]), "v"(yv[rb_][1]), "v"(yv[rb_][2]), "v"(yv[rb_][3]) : "memory"); } \
            else { bf16_t* d_ = SG + (tk_ + rb_ * 16 + fq * 4) * 512 + g * 16 + fr; \
                asm volatile("global_store_short %0, %1, off\n\tglobal_store_short %0, %2, off offset:1024\n\tglobal_store_short %0, %3, off offset:2048\n\tglobal_store_short %0, %4, off offset:3072" \
                             :: "v"(d_), "v"(pk[rb_ * 4 + 0]), "v"(pk[rb_ * 4 + 1]), "v"(pk[rb_ * 4 + 2]), "v"(pk[rb_ * 4 + 3]) : "memory"); } } } while (0)
#define S5_ITER(H) do { \
              \
            pa0 = qa0; pa1 = qa1; \
            if (H == 1) { _Pragma("unroll") for (int q = 0; q < 8; ++q) z[q] = pt[q] + dsk * bf_lo(uv[q]); } \
              \
            if (H == 1) S5_LOADPU(k); \
            if (k + 2 < ci1) S5_LOADU(k + 2, qa0, qa1); \
              \
            f32x2 bu[S5_T]; \
            _Pragma("unroll") for (int s = 0; s < S5_T; ++s) { const int t = DIR ? (S5_T - 1 - s) : s; bu[s] = *(const LAS f32x2*)(BU + t * S5_BP + 2 * lane); } \
            yv[0] = (f32x4){0.f, 0.f, 0.f, 0.f}; yv[1] = yv[0]; \
            { bf16x8 xa[2][4]; \
              _Pragma("unroll") for (int rb = 0; rb < 2; ++rb) _Pragma("unroll") for (int kb = 0; kb < 4; ++kb) xa[rb][kb] = *(const LAS bf16x8*)(XS + (rb * 16 + fr) * S5_XP + (kb * 32 + fq * 8) * 2); \
              LDS_WAIT(); \
              _Pragma("unroll") for (int q = 0; q < 8; ++q) yv[q >> 2] = __builtin_amdgcn_mfma_f32_16x16x32_bf16(xa[q >> 2][q & 3], cc[q & 3], yv[q >> 2], 0, 0, 0); } \
            __builtin_amdgcn_sched_barrier(0); \
              \
            unsigned pk[8]; _Pragma("unroll") for (int q = 0; q < 8; ++q) pk[q] = 0u; \
            _Pragma("unroll") for (int w = 0; w < 16; ++w) { \
                const bf16x8 ua_ = (w >> 3) ? pa1 : pa0; const f32x4 d_ = __builtin_amdgcn_mfma_f32_16x16x32_bf16(fq < 2 ? ua_ : zero8, bb[w & 7], (f32x4){0.f, 0.f, 0.f, 0.f}, 0, 0, 0); \
                _Pragma("unroll") for (int s2 = 0; s2 < 2; ++s2) { const int s = 2 * w + s2; const int t = DIR ? (S5_T - 1 - s) : s; float t1, t2; \
                    asm("v_fma_f32 %0, %1, %2, %3" : "=v"(t1) : "v"(nai), "v"(xi), "v"(bu[s].x)); \
                    asm("v_fma_f32 %0, %1, %2, %3" : "=v"(t2) : "v"(ai), "v"(xr), "v"(bu[s].y)); \
                    asm("v_fma_f32 %0, %1, %2, %3" : "=v"(xr) : "v"(ar), "v"(xr), "v"(t1)); \
                    asm("v_fma_f32 %0, %1, %2, %3" : "=v"(xi) : "v"(ar), "v"(xi), "v"(t2)); \
                    *(LAS unsigned*)(XS + t * S5_XP + lane * 4) = cvt_pk_bf16(xr, xi); } \
                if (H == 1 && (w & 1)) { const int q = w >> 1; pk[q] = cvt_pk_bf16(gelu_tanh(yv[q >> 2][q & 3] + z[q]), 0.f); } \
                _Pragma("unroll") for (int j_ = 0; j_ < 4; ++j_) BU[((w >> 3) * 16 + fq * 4 + j_) * S5_BP + (w & 7) * 16 + fr] = d_[j_]; \
                __builtin_amdgcn_sched_barrier(0); } \
              \
            if (k > ci0) S5_OUT(H, k - 1); \
              \
            if (k > ci0) asm volatile("s_waitcnt vmcnt(8)" ::: "memory"); else asm volatile("s_waitcnt vmcnt(0)" ::: "memory"); \
            S5_TIE_U(qa0, qa1); if (H == 1) S5_TIE_PU(); \
            LDS_WAIT(); } while (0)
#define S5_HALF(H) do { const int ci0 = (H) * (S5_NC / 2), ci1 = ((H) + 1) * (S5_NC / 2); \
            _Pragma("unroll") for (int q = 0; q < 8; ++q) { pt[q] = 0.f; uv[q] = 0u; z[q] = 0.f; } \
              \
            S5_LOADU(ci0, pa0, pa1); S5_LOADU(ci0 + 1, qa0, qa1); \
            asm volatile("s_waitcnt vmcnt(0)" ::: "memory"); S5_TIE_U(pa0, pa1); S5_TIE_U(qa0, qa1); \
            _Pragma("unroll") for (int i = 0; i < 16; ++i) S5_BUM(i, pa0, pa1); \
            LDS_WAIT(); \
            for (int k = ci0; k < ci1; ++k) S5_ITER(H); \
              \
            { bf16x8 xa[2][4]; unsigned pk[8]; \
              _Pragma("unroll") for (int rb = 0; rb < 2; ++rb) _Pragma("unroll") for (int kb = 0; kb < 4; ++kb) xa[rb][kb] = *(const LAS bf16x8*)(XS + (rb * 16 + fr) * S5_XP + (kb * 32 + fq * 8) * 2); \
              LDS_WAIT(); \
              yv[0] = (f32x4){0.f, 0.f, 0.f, 0.f}; yv[1] = yv[0]; \
              _Pragma("unroll") for (int q = 0; q < 8; ++q) yv[q >> 2] = __builtin_amdgcn_mfma_f32_16x16x32_bf16(xa[q >> 2][q & 3], cc[q & 3], yv[q >> 2], 0, 0, 0); \
              asm volatile("s_waitcnt vmcnt(0)" ::: "memory"); \
              _Pragma("unroll") for (int q = 0; q < 8; ++q) pk[q] = 0u; \
              if (H == 1) { S5_TIE_PU(); _Pragma("unroll") for (int q = 0; q < 8; ++q) pk[q] = cvt_pk_bf16(gelu_tanh(yv[q >> 2][q & 3] + pt[q] + dsk * bf_lo(uv[q])), 0.f); } \
              const int k = ci1; S5_OUT(H, k - 1); } \
            VM_WAIT(); \
            __syncthreads(); } while (0)
        { bf16x8 pa0, pa1, qa0 = zero8, qa1 = zero8; float pt[8], z[8]; unsigned uv[8]; f32x4 yv[2];
          S5_HALF(0);
          S5_HALF(1); }
#undef S5_ITER
#undef S5_HALF
#undef S5_TC
#undef S5_LOADU
#undef S5_LOADPU
#undef S5_TIE_U
#undef S5_TIE_PU
#undef S5_BUM
#undef S5_OUT
}
__device__ __forceinline__ void s5_phase(LAS unsigned char* lds, const bf16_t* U, float* YP, bf16_t* SG, const float* s5ab, const bf16_t* s5bb, const bf16_t* s5cc, const float* dskip, const float* we1, const float* we2, const float* gffn, unsigned char* ws, const int G, const int c, const int wid, const bool doconv = true, const bool doscan = true) {
    const int lane = fresh_lane(), tid = wid * 64 + lane, fr = lane & 15, fq = lane >> 4;
    for (int pp = c; pp < NBATCH * 32 / 2; pp += G) {
      if (wid < 4) {
        const int pair = pp * 2 + ((wid >> 1) & 1);
        if (!doscan) { __syncthreads(); __syncthreads(); }
        else if (wid & 1) s5_scan_wave<1>(lds, U, YP, SG, s5ab, s5bb, s5cc, dskip, pair, wid, lane); else s5_scan_wave<0>(lds, U, YP, SG, s5ab, s5bb, s5cc, dskip, pair, wid, lane);
      } else {
        LAS unsigned char* cscr = lds + 4 * S5_WAVE + (wid - 4) * 8192; const int gw4 = c * 4 + (wid - 4), n4 = G * 4;
        if (pp == c && doconv) expert_convert<true>(we1, we2, gffn, ws, cscr, 0, 12288, gw4, n4, lane);
        VM_WAIT(); __syncthreads();
        if (pp == c && doconv) { expert_convert<true>(we1, we2, gffn, ws, cscr, 12288, 16384, gw4, n4, lane); expert_convert<false>(we1, we2, gffn, ws, cscr, 16384, 24576, gw4, n4, lane); }
        VM_WAIT(); __syncthreads();
      }
    }
}

__device__ __forceinline__ void router_phase(LAS unsigned char* lds, const bf16_t* __restrict__ H2B, const float* ss2, const bf16_t* wr, const float* brouter, int* topi, float* gatev, int* gcnt, int* rowtok, float* roww, float* rscale, int* slotof, const int G, const int c, const int wid) {
    const int lane = fresh_lane(), tid = wid * 64 + lane, fr = lane & 15, fq = lane >> 4;
    LAS int* hist = (LAS int*)(lds + TAB_OFF) + 576;
    LAS float* lg = (LAS float*)(lds + 131072 + wid * 2112);
    static_assert(131072 + 8 * 2112 <= PHASE_LDS, "router LDS");
    if (tid < 32) hist[tid] = 0;
    { const u32x4* src = (const u32x4*)wr + tid;
#pragma unroll 1
      for (int i0 = 0; i0 < 16; i0 += 8) { u32x4 t[8];
#pragma unroll
          for (int i = 0; i < 8; ++i) t[i] = src[(i0 + i) * 512];
#pragma unroll
          for (int i = 0; i < 8; ++i) *(LAS u32x4*)(lds + ((i0 + i) * 512 + tid) * 16) = t[i]; } }
    __syncthreads();
    for (int task = c * 8 + wid; task < NTOK / 16; task += G * 8) {
        const int tok0 = task * 16;
        f32x4 a0 = (f32x4){0.f, 0.f, 0.f, 0.f}, a1 = a0;
        const bf16_t* ap = H2B + (size_t)(tok0 + fr) * 1024 + fq * 8;
        const LAS unsigned char* bp = lds + lane * 16;
#pragma unroll 1
        for (int k0 = 0; k0 < 32; k0 += 16) { bf16x8 av[16];
#pragma unroll
            for (int i = 0; i < 16; ++i) av[i] = *(const bf16x8*)(ap + (k0 + i) * 32);
#pragma unroll
            for (int i = 0; i < 16; ++i) { const LAS unsigned char* q = bp + (k0 + i) * 4096;
                a0 = __builtin_amdgcn_mfma_f32_16x16x32_bf16(av[i], *(const LAS bf16x8*)(q), a0, 0, 0, 0); a0 = __builtin_amdgcn_mfma_f32_16x16x32_bf16(av[i], *(const LAS bf16x8*)(q + 2048), a0, 0, 0, 0);
                a1 = __builtin_amdgcn_mfma_f32_16x16x32_bf16(av[i], *(const LAS bf16x8*)(q + 1024), a1, 0, 0, 0); a1 = __builtin_amdgcn_mfma_f32_16x16x32_bf16(av[i], *(const LAS bf16x8*)(q + 3072), a1, 0, 0, 0); } }
        const float br0 = brouter[fr], br1 = brouter[16 + fr];
#pragma unroll
        for (int j = 0; j < 4; ++j) { const int t = fq * 4 + j; const float rs = row_rstd16(ss2, tok0 + t); lg[t * 33 + fr] = a0[j] * rs + br0; lg[t * 33 + 16 + fr] = a1[j] * rs + br1; }
        LDS_WAIT();
        if (lane < 16) {
            float v0 = -3e38f, v1 = -3e38f, v2 = -3e38f, v3 = -3e38f; int i0 = 0, i1 = 0, i2 = 0, i3 = 0;
#pragma unroll
            for (int e = 0; e < 32; ++e) { const float v = lg[lane * 33 + e];
                if (v > v0) { v3 = v2; i3 = i2; v2 = v1; i2 = i1; v1 = v0; i1 = i0; v0 = v; i0 = e; }
                else if (v > v1) { v3 = v2; i3 = i2; v2 = v1; i2 = i1; v1 = v; i1 = e; }
                else if (v > v2) { v3 = v2; i3 = i2; v2 = v; i2 = e; }
                else if (v > v3) { v3 = v; i3 = e; } }
            const float e1 = __expf(v1 - v0), e2 = __expf(v2 - v0), e3 = __expf(v3 - v0), inv = 1.0f / (1.0f + e1 + e2 + e3);
            const int tok = tok0 + lane;
            *(int4*)(topi + (size_t)tok * 4) = make_int4(i0, i1, i2, i3);
            *(f32x4*)(gatev + (size_t)tok * 4) = (f32x4){inv, e1 * inv, e2 * inv, e3 * inv};
            atomicAdd((int*)&hist[i0], 1); atomicAdd((int*)&hist[i1], 1); atomicAdd((int*)&hist[i2], 1); atomicAdd((int*)&hist[i3], 1);
        }
        LDS_WAIT();
    }
    __syncthreads();
    LAS int* run = (LAS int*)(lds + TAB_OFF) + 608; LAS int* base = (LAS int*)(lds + TAB_OFF) + 640;
    if (tid < 32) { base[tid] = atomicAdd(&gcnt[tid], hist[tid]); run[tid] = 0; }
    __syncthreads();
    for (int task = c * 8 + wid; task < NTOK / 16; task += G * 8) {
        if (lane < 16) { const int tok = task * 16 + lane; const int4 ti = *(const int4*)(topi + (size_t)tok * 4); const f32x4 gv = *(const f32x4*)(gatev + (size_t)tok * 4);
            const float rs = row_rstd16(ss2, tok); const int ee[4] = {ti.x, ti.y, ti.z, ti.w}; int sl[4];
#pragma unroll
            for (int k = 0; k < 4; ++k) { const int r = base[ee[k]] + atomicAdd((int*)&run[ee[k]], 1); const size_t ix = (size_t)ee[k] * MOE_CAP + r; sl[k] = (ee[k] << 16) | r; rowtok[ix] = tok; roww[ix] = gv[k]; rscale[ix] = rs; }
            *(int4*)(slotof + (size_t)tok * 4) = make_int4(sl[0], sl[1], sl[2], sl[3]); }
    }
}

__device__ __forceinline__ void moe_tables(LAS unsigned char* lds, const int* gcnt, const int G, const int c, const int wid) {
    LAS int* T = (LAS int*)(lds + TAB_OFF); LAS int* blk_e = T; LAS int* tot = T + 672; LAS int* nblkp = T + 704; LAS int* fb = T + 720;
    const int tid = wid * 64 + fresh_lane();
    if (wid == 0) {
        const int l = tid; const int n = (l < 32) ? gcnt[l & 31] : 0; const int nbe = (n + 255) >> 8; int inc = nbe;
#pragma unroll
        for (int o = 1; o < 32; o <<= 1) { const int v = __shfl_up(inc, o); if (l >= o) inc += v; }
        const int pre = inc - nbe;
        if (l < 32) { tot[l] = n; fb[l] = pre; for (int k = 0; k < nbe; ++k) blk_e[pre + k] = l; }
        if (l == 31) nblkp[0] = inc; }
    __syncthreads();
}
__device__ __forceinline__ void moe_pad_rows(LAS unsigned char* lds, int* rowtok, float* roww, float* rscale, const int wid) {
    const LAS int* tot = (const LAS int*)(lds + TAB_OFF) + 672; const int tid = wid * 64 + fresh_lane();
    for (int e = 0; e < 32; ++e) { const int n = tot[e], pe = ((n + 255) >> 8) << 8;
        for (int r = n + tid; r < pe; r += 512) { const size_t ix = (size_t)e * MOE_CAP + r; rowtok[ix] = 0; roww[ix] = 0.f; rscale[ix] = 0.f; } }
    VM_WAIT(); __syncthreads();
}
__device__ __forceinline__ void combine_phase(LAS unsigned char* lds, const bf16_t* __restrict__ H2B, const unsigned char* __restrict__ YS, const int* slotof, const int* gcnt, const float* gfin, float* out, const int G, const int c, const int wid) {
    const int lane = fresh_lane(), tid = wid * 64 + lane;
    moe_tables(lds, gcnt, G, c, wid); const LAS int* fb = (const LAS int*)(lds + TAB_OFF) + 720;
    f32x4 g[4];
#pragma unroll
    for (int q = 0; q < 4; ++q) g[q] = *(const f32x4*)(gfin + q * 256 + lane * 4);
    for (int tok = c * 8 + wid; tok < NTOK; tok += G * 8) {
        const int4 sl = *(const int4*)(slotof + (size_t)tok * 4); const int ss[4] = {fb[sl.x >> 16] * 256 + (sl.x & 0xffff), fb[sl.y >> 16] * 256 + (sl.y & 0xffff), fb[sl.z >> 16] * 256 + (sl.z & 0xffff), fb[sl.w >> 16] * 256 + (sl.w & 0xffff)};
        f32x4 v[4]; float sq = 0.f;
#pragma unroll
        for (int q = 0; q < 4; ++q) { const u32x2 hw = *(const u32x2*)(H2B + (size_t)tok * 1024 + q * 256 + lane * 4); v[q] = (f32x4){bf_lo(hw.x), bf_hi(hw.x), bf_lo(hw.y), bf_hi(hw.y)}; }
#pragma unroll
        for (int k = 0; k < 4; ++k)
#pragma unroll
            for (int q = 0; q < 4; ++q) { const unsigned yw = *(const unsigned*)(YS + (size_t)ss[k] * 1024 + q * 256 + lane * 4);
                const f32x2 y01 = __builtin_amdgcn_cvt_pk_f32_fp8((int)yw, false), y23 = __builtin_amdgcn_cvt_pk_f32_fp8((int)yw, true); v[q] += (f32x4){y01.x, y01.y, y23.x, y23.y}; }
#pragma unroll
        for (int q = 0; q < 4; ++q) sq += (v[q][0] * v[q][0] + v[q][1] * v[q][1]) + (v[q][2] * v[q][2] + v[q][3] * v[q][3]);
        const float rs = __builtin_amdgcn_rsqf(wave_sum(sq) * (1.0f / DM) + EPS);
#pragma unroll
        for (int q = 0; q < 4; ++q) *(f32x4*)(out + (size_t)tok * 1024 + q * 256 + lane * 4) = v[q] * rs * g[q];
    }
}
constexpr int NPHASE = 14;
#ifndef S5P_CONV
#define S5P_CONV(r) true
#define S5P_SCAN(r) true
#endif
__global__ void __launch_bounds__(512, 2) fwd_kernel(Params P) {
    extern __shared__ __attribute__((aligned(16))) unsigned char lds_raw[];
    LAS unsigned char* lds = (LAS unsigned char*)lds_raw;
    const int G = gridDim.x, c = blockIdx.x, wid = __builtin_amdgcn_readfirstlane(threadIdx.x >> 6);
    unsigned char* ws = P.ws;
    volatile LAS unsigned* MISC = (volatile LAS unsigned*)(lds + MISC_OFF);
    if (threadIdx.x < 64) MISC[threadIdx.x] = 0u;
    __syncthreads();
    const int lo = P.ph_lo, hi = P.ph_hi;
    const bool multi = (hi - lo) > 1;
    XcdBarrier bar; bar.bar = (unsigned*)(ws + WS_CTL); bar.x = 0; bar.st = nullptr;
    if (multi) bar = xcd_barrier_post((unsigned*)(ws + WS_CTL), MISC + 8);
#ifndef ONLY_PHASE
#define ONLY_PHASE -1
#endif
#define IN(k) ((ONLY_PHASE < 0 || ONLY_PHASE == (k)) && lo <= (k) && (k) < hi)
#ifndef REP_MASK
#define REP_MASK 0
#endif
#define REPS(k) (((REP_MASK >> (k)) & 1) ? 2 : 1)
#define SEAM(k) do { if (IN(k) && IN((k) + 1)) xcd_barrier(bar, wid); } while (0)
#define SEAM2(k) do { if (IN(k) && IN((k) + 2)) xcd_barrier(bar, wid); } while (0)
    KParams kp0 = (KParams)__builtin_amdgcn_kernarg_segment_ptr(); unsigned char* const ws0 = ws;
#define ENV() KParams pk = kp0; unsigned char* w = ws0; asm volatile("" : "+s"(pk), "+s"(w))
#define BF(off) ((bf16_t*)(w + (off)))
#define F32(off) ((float*)(w + (off)))
#define I32(off) ((int*)(w + (off)))
    constexpr size_t TS1024 = 256 * 1024 * 2, TS512 = 256 * 512 * 2;

    for (int rep_ = 0; rep_ < REPS(0); ++rep_) if (IN(0)) { ENV(); prologue_phase(lds, pk, w, G, c, wid); }
    SEAM(0);
    for (int rep_ = 0; rep_ < REPS(1); ++rep_) if (IN(1)) { ENV();
        P1Sched S{(const char*)(w + WS_XB), (const char*)(w + WS_WIN), (const char*)(w + WS_MEMN), (const char*)(w + WS_WXK), (const char*)(w + WS_WXV), G, c};
        EpiP1 E{w, F32(WS_RSTD0), (const float*)(w + WS_ROPE)};
        pg8::gemm_phase<EpiP1, P1Sched, false, false, false, true>(lds, wid, 1024, 1024, 1024, S, E);
    }
    SEAM(1);
    for (int rep_ = 0; rep_ < REPS(2); ++rep_) if (IN(2)) {
        { ENV(); diff_attn_phase<0>(lds, BF(WS_Q), BF(WS_K), BF(WS_VT), BF(WS_OAS), pk->in[I_SUBLN], *(const float*)(w + WS_LAM), G, c, wid); }
#ifdef ATTN_VAR
        { ENV(); diff_attn_phase<ATTN_VAR>(lds, BF(WS_Q), BF(WS_K), BF(WS_VT), (bf16_t*)(w + 900 * MiB), pk->in[I_SUBLN], *(const float*)(w + WS_LAM), G, c, wid); }
#endif
        for (int r2_ = 0; r2_ < REPS(15); ++r2_) { ENV(); s5_phase(lds, BF(WS_U), F32(WS_YP), BF(WS_SG), (const float*)(w + WS_S5AB), (const bf16_t*)(w + WS_S5BB), (const bf16_t*)(w + WS_S5CC), pk->in[I_SSMD], pk->in[I_WE1], pk->in[I_WE2], pk->in[I_NFFNG], w, G, c, wid, S5P_CONV(r2_), S5P_SCAN(r2_)); }
    }
    SEAM(2);
    for (int rep_ = 0; rep_ < REPS(3); ++rep_) if (IN(3)) {
        { ENV(); CrossSched S{(const char*)(w + WS_MEMN), (const char*)(w + WS_WXK), (const char*)(w + WS_WXV), G, c}; EpiP1 E{w, F32(WS_RSTD0), (const float*)(w + WS_ROPE)};
          pg8::gemm_phase<EpiP1, CrossSched, false, false, false, true>(lds, wid, 1024, 1024, 1024, S, E); }
        __syncthreads();
        ENV();
        GluSched S{SimpleSched{(const char*)(w + WS_SG), (const char*)(w + WS_WGLU), TS512, TS512, 128, 4, G, c}};
        EpiGlu E{BF(WS_OAS)};
        pg8::gemm_phase<EpiGlu, GluSched, false>(lds, wid, 512, 512, 512, S, E);
#ifdef GLU_PROBE
        __syncthreads();
        { EpiProbe<GLU_PROBE> E2{(bf16_t*)(w + 900 * MiB)}; pg8::gemm_phase<EpiProbe<GLU_PROBE>, GluSched, false>(lds, wid, 512, 512, 512, S, E2); }
#endif
    }
    SEAM(3);
    for (int rep_ = 0; rep_ < REPS(4); ++rep_) if (IN(4)) { ENV();
        SimpleSched S{(const char*)(w + WS_OAS), (const char*)(w + WS_WBA), TS1024, TS1024, 128, 4, G, c}; EpiGateOut E{BF(WS_GS), BF(WS_MG)}; MidGate MHK{BF(WS_GA), BF(WS_GS)};
        #ifdef NOMID_TEST
        pg8::gemm_phase<EpiGateOut, SimpleSched, false, false, false, true>(lds, wid, 1024, 1024, 1024, S, E);
#else
        pg8::gemm_phase<EpiGateOut, SimpleSched, false, false, false, true, MidGate>(lds, wid, 1024, 1024, 1024, S, E, MHK);
#endif
    }
    SEAM(4);
    for (int rep_ = 0; rep_ < REPS(5); ++rep_) if (IN(5)) { ENV();
        SimpleSched S{(const char*)(w + WS_MG), (const char*)(w + WS_WMIX), TS1024, TS1024, 128, 4, G, c}; EpiResid<false, false> E{(const void*)(w + WS_XB), BF(WS_H1B), F32(WS_SS1), nullptr};
        pg8::gemm_phase<EpiResid<false, false>, SimpleSched, false, false, false, true>(lds, wid, 1024, 1024, 1024, S, E);
    }
    SEAM(5);
    for (int rep_ = 0; rep_ < REPS(6); ++rep_) if (IN(6)) {
#pragma unroll 1
        for (int i = 0; ; ++i) { ENV();
            SimpleSched S{(const char*)(w + WS_H1B), (const char*)(w + WS_WXQ), TS1024, TS1024, 128, 4, G, c}; GUnit uu;
            if (!S.next(i, uu)) break;
            OneUnitSched S1{S, i}; EpiXq E{BF(WS_XQ), F32(WS_SS1)};
            pg8::gemm_phase<EpiXq, OneUnitSched, false, false, false, true>(lds, wid, 1024, 1024, 1024, S1, E);
            cross_attn_unit(lds, BF(WS_XQ), BF(WS_XK), BF(WS_XVT), BF(WS_XO), uu.pm >> 3, uu.pn, uu.pm & 7, wid);
        }
    }
    SEAM(7);
    for (int rep_ = 0; rep_ < REPS(8); ++rep_) if (IN(8)) { ENV();
        SimpleSched S{(const char*)(w + WS_XO), (const char*)(w + WS_WXO), TS1024, TS1024, 128, 4, G, c}; EpiResid<false> E{(const void*)(w + WS_H1B), BF(WS_H2B), F32(WS_SS2), w + WS_H2F8};
        pg8::gemm_phase<EpiResid<false>, SimpleSched, false, false, false, true>(lds, wid, 1024, 1024, 1024, S, E);
    }
    SEAM(8);
    for (int rep_ = 0; rep_ < REPS(9); ++rep_) if (IN(9)) { ENV(); router_phase(lds, BF(WS_H2B), F32(WS_SS2), (const bf16_t*)(w + WS_WR), pk->in[I_BROUTER], I32(WS_TOPI), F32(WS_GATE), I32(WS_GCNT), I32(WS_ROWTOK), F32(WS_ROWW), F32(WS_RSCALE), I32(WS_SLOT), G, c, wid); }
    SEAM2(9);
    for (int rep_ = 0; rep_ < REPS(11); ++rep_) if (IN(11)) { ENV();
        moe_tables(lds, I32(WS_GCNT), G, c, wid);
        moe_pad_rows(lds, I32(WS_ROWTOK), F32(WS_ROWW), F32(WS_RSCALE), wid);
        const LAS int* T = (const LAS int*)(lds + TAB_OFF);
        MoeSched S{(const char*)(w + WS_H2F8), (const char*)(w + WS_WE1), I32(WS_ROWTOK), T, __builtin_amdgcn_readfirstlane(T[704]), 8, G, c, (size_t)2048 * 1024, true};
        EpiE1 E{w + WS_ACT, F32(WS_RSCALE), pk->in[I_BE1]};
        pg8::gemm_phase<EpiE1, MoeSched, true, true>(lds, wid, 512, 512, 512, S, E);
    }
    SEAM(11);
    for (int rep_ = 0; rep_ < REPS(12); ++rep_) if (IN(12)) { ENV();
        moe_tables(lds, I32(WS_GCNT), G, c, wid);
        const LAS int* T = (const LAS int*)(lds + TAB_OFF);
        MoeSched S{(const char*)(w + WS_ACT), (const char*)(w + WS_WE2), I32(WS_ROWTOK), T, __builtin_amdgcn_readfirstlane(T[704]), 4, G, c, (size_t)1024 * 1024, false};
        EpiE2 E{w + WS_YS, F32(WS_ROWW), pk->in[I_BE2]};
        pg8::gemm_phase<EpiE2, MoeSched, false, true, true, true>(lds, wid, 512, 512, 512, S, E);
#ifdef E2_PROBE
        __syncthreads();
        { EpiProbe<0> E2{(bf16_t*)(w + 900 * MiB)}; pg8::gemm_phase<EpiProbe<0>, MoeSched, false, true, true, true>(lds, wid, 512, 512, 512, S, E2); }
#endif
    }
    SEAM(12);
    for (int rep_ = 0; rep_ < REPS(13); ++rep_) if (IN(13)) { ENV(); combine_phase(lds, BF(WS_H2B), w + WS_YS, I32(WS_SLOT), I32(WS_GCNT), pk->in[I_NFING], pk->out, G, c, wid); }
#undef ENV
#undef BF
#undef F32
#undef I32
#undef IN
#undef SEAM
}

#ifndef N_LAUNCHES
#define N_LAUNCHES 1
#endif
extern "C" void kernel_launch(void* const* d_in, const int* in_sizes, int n_in, void* d_out, int out_size, void* d_ws, size_t ws_size, hipStream_t stream) {
    static int grid = 0;
    if (grid == 0) {
        if (n_in != 34 || out_size != NTOK * DM || ws_size < WS_END) { fprintf(stderr, "kernel_launch: unexpected shapes (n_in %d out %d ws %zu)\n", n_in, out_size, ws_size); grid = -1; return; }
        int dev = 0, cus = 0, per_cu = 0;
        if (hipGetDevice(&dev) != hipSuccess || hipDeviceGetAttribute(&cus, hipDeviceAttributeMultiprocessorCount, dev) != hipSuccess) { grid = -1; return; }
        if (hipFuncSetAttribute((const void*)fwd_kernel, hipFuncAttributeMaxDynamicSharedMemorySize, LDS_BYTES) != hipSuccess) { fprintf(stderr, "kernel_launch: hipFuncSetAttribute failed\n"); grid = -1; return; }
        if (hipOccupancyMaxActiveBlocksPerMultiprocessor(&per_cu, (const void*)fwd_kernel, 512, LDS_BYTES) != hipSuccess || per_cu < 1) { fprintf(stderr, "kernel_launch: occupancy query says %d\n", per_cu); }
        (void)hipGetLastError();
        grid = cus;
    }
    if (grid < 0) return;
    (void)hipMemsetAsync((char*)d_ws + WS_CTL, 0, CTL_ZERO_BYTES, stream);
    Params p{};
    for (int i = 0; i < 34; ++i) p.in[i] = (const float*)d_in[i];
    p.out = (float*)d_out; p.ws = (unsigned char*)d_ws;
#if N_LAUNCHES == 1
    p.ph_lo = 0; p.ph_hi = NPHASE;
    hipLaunchKernelGGL(fwd_kernel, dim3(grid), dim3(512), LDS_BYTES, stream, p);
#else
    for (int k = 0; k < NPHASE; ++k) { p.ph_lo = k; p.ph_hi = k + 1; hipLaunchKernelGGL(fwd_kernel, dim3(grid), dim3(512), LDS_BYTES, stream, p); }
#endif
}
```

```cpp
#include <hip/hip_runtime.h>
#include <cstdio>
#include <cstdint>

#define LAS __attribute__((address_space(3)))
#define GAS __attribute__((address_space(1)))
typedef unsigned short bf16_t;
typedef short bf16x8 __attribute__((ext_vector_type(8)));
typedef float f32x4 __attribute__((ext_vector_type(4)));
typedef float f32x2 __attribute__((ext_vector_type(2)));
typedef float f32x16 __attribute__((ext_vector_type(16)));
typedef unsigned u32x4 __attribute__((ext_vector_type(4)));
typedef unsigned u32x2 __attribute__((ext_vector_type(2)));

constexpr int NBATCH = 16, SEQ = 2048, DM = 1024, NTOK = NBATCH * SEQ;
constexpr int NMEM = 256, NMEMTOK = NBATCH * NMEM;
constexpr int NEXP = 32, TOPK = 4, NPAD = NTOK * TOPK + NEXP * 256, MAXBLK = NPAD / 256;
constexpr float EPS = 1e-6f;
constexpr float LOG2E = 1.4426950408889634f;
constexpr float QSCALE = 0.125f * LOG2E;
constexpr float XQSCALE = 0.0625f * LOG2E;
constexpr float LAMBDA_INIT = 0.2f;

constexpr size_t MiB = 1u << 20;
constexpr size_t WS_CTL = 0, CTL_ZERO_BYTES = 64 * 1024;
constexpr size_t WS_RSTD0 = 1 * MiB;
constexpr size_t WS_SS1 = 2 * MiB, WS_SS2 = 4 * MiB;
constexpr size_t WS_ROPE = 6 * MiB;
constexpr size_t WS_S5AB = 7 * MiB;
constexpr size_t WS_S5BB = WS_S5AB + 64 * 1024;
constexpr size_t WS_S5CC = WS_S5BB + 256 * 1024;
constexpr size_t WS_LAM = WS_S5CC + 256 * 1024;
constexpr size_t WS_WR = 8 * MiB;
constexpr size_t WS_TOPI = 9 * MiB, WS_GATE = WS_TOPI + 512 * 1024;
constexpr size_t WS_SLOT = 10 * MiB;
constexpr size_t WS_CNTWG = WS_SLOT + 512 * 1024;
constexpr int MOE_CAP = 32768 + 256;
constexpr size_t WS_ROWTOK = 256 * MiB, WS_ROWW = 262 * MiB, WS_RSCALE = 268 * MiB;
constexpr size_t WS_GCNT = WS_CTL + 16384;
constexpr size_t WS_WIN = 17 * MiB;
constexpr size_t WS_WGLU = 25 * MiB, WS_WBA = 26 * MiB, WS_WBS = 27 * MiB, WS_WMIX = 28 * MiB, WS_WXQ = 30 * MiB, WS_WXK = 32 * MiB, WS_WXV = 34 * MiB, WS_WXO = 36 * MiB;
constexpr size_t WS_WE1 = 38 * MiB, WS_WE2 = 166 * MiB;
constexpr size_t WS_MEMN = 232 * MiB, WS_XK = 240 * MiB, WS_XVT = 248 * MiB;
constexpr size_t WS_XB = 256 * MiB, WS_M1 = 672 * MiB;
constexpr size_t WS_Q = 320 * MiB, WS_K = 352 * MiB, WS_MG = WS_Q;
constexpr size_t WS_VT = 384 * MiB, WS_U = 416 * MiB;
constexpr size_t WS_GA = 448 * MiB, WS_XQ = WS_GA;
constexpr size_t WS_GS = 512 * MiB, WS_XO = WS_GS;
constexpr size_t WS_OAS = 576 * MiB, WS_SG = 640 * MiB, WS_YP = 672 * MiB, WS_H1B = 736 * MiB, WS_H2B = 800 * MiB;
constexpr size_t WS_XS8 = 256 * MiB;
constexpr size_t WS_ACT = 392 * MiB, WS_YS = 528 * MiB;
constexpr size_t WS_H2F8 = 864 * MiB;
constexpr size_t WS_END = 896 * MiB;
constexpr float W8SCALE = 64.0f, W8INV = 1.0f / 64.0f;
static_assert(WS_XS8 + (size_t)NPAD * 1024 <= WS_ACT && WS_ACT + (size_t)NPAD * 1024 <= WS_YS && WS_YS + (size_t)NPAD * 2048 <= WS_H2B, "overlay map");

constexpr int RING_BYTES = 131072;
constexpr int LDS_BYTES = 163840;
constexpr int PHASE_LDS = LDS_BYTES - 4096;
constexpr int MISC_OFF = PHASE_LDS;
constexpr int TAB_OFF = PHASE_LDS + 256;

__device__ __forceinline__ unsigned cvt_pk_bf16(float lo, float hi) { unsigned r; asm("v_cvt_pk_bf16_f32 %0, %1, %2" : "=v"(r) : "v"(lo), "v"(hi)); return r; }
__device__ __forceinline__ unsigned pack4_fp8(float a, float b, float c, float d) { int w = 0; w = __builtin_amdgcn_cvt_pk_fp8_f32(a, b, w, false); w = __builtin_amdgcn_cvt_pk_fp8_f32(c, d, w, true); return (unsigned)w; }
__device__ __forceinline__ float bf_lo(unsigned u) { return __uint_as_float(u << 16); }
__device__ __forceinline__ float bf_hi(unsigned u) { return __uint_as_float(u & 0xffff0000u); }
__device__ __forceinline__ float fast_sigmoid(float x) { return __builtin_amdgcn_rcpf(1.0f + __builtin_amdgcn_exp2f(-x * LOG2E)); }
__device__ __forceinline__ float wave_sum(float v) {
#pragma unroll
    for (int o = 1; o < 64; o <<= 1) v += __shfl_xor(v, o);
    return v;
}
__device__ __forceinline__ int fresh_lane() { int l; asm volatile("v_mbcnt_lo_u32_b32 %0, -1, 0\n\tv_mbcnt_hi_u32_b32 %0, -1, %0" : "=v"(l)); return l; }
#define LDS_WAIT() asm volatile("s_waitcnt lgkmcnt(0)" ::: "memory")
#define VM_WAIT() asm volatile("s_waitcnt vmcnt(0)" ::: "memory")

#define XB_TMO      128
#define XB_XCNT(j)  (256  + 64 * (j))
#define XB_XSUB(j)  (1280 + 64 * (j))
#define XB_XGEN(j)  (2304 + 64 * (j))
#define XB_TOP      3328
#define XB_TOPGEN   3392
#define XCD_BAR_WORDS 3456
#define XB_SPIN_CAP (1u << 18)
__device__ __forceinline__ unsigned xb_ld(unsigned* p)              { return __hip_atomic_load(p, __ATOMIC_RELAXED, __HIP_MEMORY_SCOPE_AGENT); }
__device__ __forceinline__ unsigned xb_add(unsigned* p, unsigned v) { return __hip_atomic_fetch_add(p, v, __ATOMIC_RELAXED, __HIP_MEMORY_SCOPE_AGENT); }
__device__ __forceinline__ unsigned xb_xcc_id() { return (unsigned)__builtin_amdgcn_s_getreg((3 << 11) | 20) & 0xFu; }
#define XB_SPIN(cond, bar) do { unsigned _sp = 0; while (cond) { __builtin_amdgcn_s_sleep(1); \
    if ((++_sp & 255u) == 0u) { if (xb_ld(&(bar)[XB_TMO])) break; if (_sp > XB_SPIN_CAP) { atomicAdd(&(bar)[XB_TMO], 1u); break; } } } } while (0)
struct XcdBarrier { unsigned* bar; unsigned x; volatile LAS unsigned* st; };
__device__ __forceinline__ XcdBarrier xcd_barrier_post(unsigned* bar, volatile LAS unsigned* st) {
    XcdBarrier b; b.bar = bar; b.x = xb_xcc_id(); b.st = st;
    if (threadIdx.x == 0) (void)xb_add(&bar[XB_XCNT(b.x)], 1u);
    return b;
}
__device__ __forceinline__ void xcd_barrier_complete(unsigned* bar, unsigned x, unsigned& nloc, unsigned& nx) {
    const unsigned G = gridDim.x * gridDim.y * gridDim.z;
    unsigned sum, cnt, mine, sp = 0u;
    for (;;) {
        sum = 0u; cnt = 0u; mine = 0u;
#pragma unroll
        for (unsigned j = 0; j < 16; ++j) { const unsigned c = xb_ld(&bar[XB_XCNT(j)]); sum += c; cnt += (c > 0u) ? 1u : 0u; mine = (j == x) ? c : mine; }
        if (sum == G) break;
        __builtin_amdgcn_s_sleep(1);
        if ((++sp & 255u) == 0u) { if (xb_ld(&bar[XB_TMO])) break; if (sp > XB_SPIN_CAP) { atomicAdd(&bar[XB_TMO], 1u); break; } }
    }
    nloc = mine > 0u ? mine : 1u; nx = cnt > 0u ? cnt : 1u;
}
__device__ __forceinline__ void xcd_barrier(const XcdBarrier& b, const int wid) {
    asm volatile("s_waitcnt vmcnt(0)" ::: "memory");
    __syncthreads();
    if (wid == 0 && fresh_lane() == 0) {
        unsigned* bar = b.bar;
        __builtin_amdgcn_s_waitcnt(0);
        unsigned nloc = b.st[0], nx = b.st[1];
        if (nloc == 0u) { xcd_barrier_complete(bar, b.x, nloc, nx); b.st[0] = nloc; b.st[1] = nx; }
        const unsigned old = xb_add(&bar[XB_XSUB(b.x)], 1u);
        const unsigned gen = old / nloc;
#ifndef XB_FLATREL
#define XB_FLATREL 0
#endif
#if XB_FLATREL
        if (old + 1u == (gen + 1u) * nloc) {
            __builtin_amdgcn_fence(__ATOMIC_RELEASE, "agent");
            asm volatile("s_waitcnt vmcnt(0)" ::: "memory");
            const unsigned og = xb_add(&bar[XB_TOP], 1u);
            const unsigned tg = og / nx;
            if (og + 1u == (tg + 1u) * nx) {
#pragma unroll
                for (unsigned j = 0; j < 16; ++j) (void)xb_add(&bar[XB_XGEN(j)], 1u);
            }
        }
        XB_SPIN(xb_ld(&bar[XB_XGEN(b.x)]) == gen, bar);
        __builtin_amdgcn_fence(__ATOMIC_ACQUIRE, "agent");
        asm volatile("s_waitcnt vmcnt(0)" ::: "memory");
#else
        if (old + 1u == (gen + 1u) * nloc) {
            __builtin_amdgcn_fence(__ATOMIC_RELEASE, "agent");
            asm volatile("s_waitcnt vmcnt(0)" ::: "memory");
            const unsigned og = xb_add(&bar[XB_TOP], 1u);
            const unsigned tg = og / nx;
            if (og + 1u == (tg + 1u) * nx) xb_add(&bar[XB_TOPGEN], 1u);
            else XB_SPIN(xb_ld(&bar[XB_TOPGEN]) == tg, bar);
            __builtin_amdgcn_fence(__ATOMIC_ACQUIRE, "agent");
            xb_add(&bar[XB_XGEN(b.x)], 1u);
            asm volatile("s_waitcnt vmcnt(0)" ::: "memory");
        } else {
            XB_SPIN(xb_ld(&bar[XB_XGEN(b.x)]) == gen, bar);
            __builtin_amdgcn_fence(__ATOMIC_ACQUIRE, "agent");
            asm volatile("s_waitcnt vmcnt(0)" ::: "memory");
        }
#endif
    }
    __syncthreads();
}

namespace pg8 {
constexpr int BM = 256, BK = 64, HALF = 128, HTB = HALF * BK * 2, NXCD = 8, WGM = 8;
__device__ __forceinline__ int lds_byte(int r, int c) { const int st = (r >> 4) * 2 + (c >> 5), rr = r & 15, cc = c & 31, ob = rr * 64 + cc * 2; return st * 1024 + (ob ^ (((ob >> 9) & 1) << 5)); }
__device__ __forceinline__ void stage_rc(int b, int& R, int& C) { const int st = b / 1024, sb = b % 1024, swz = sb ^ (((sb >> 9) & 1) << 5); R = (st >> 1) * 16 + swz / 64; C = (st & 1) * 32 + (swz % 64) / 2; }
__device__ __forceinline__ int perm32(int rho) { const int n = rho >> 4, i = rho & 15; return 8 * (i >> 2) + 4 * n + (i & 3); }

struct GUnit { const char* A; const char* B; const int* idx; int pm, pn, kind, e; };

typedef int v4i_t __attribute__((ext_vector_type(4))); typedef int v8i_t __attribute__((ext_vector_type(8)));
__device__ __forceinline__ v8i_t cat8(const bf16x8 a, const bf16x8 b) { const v4i_t x = __builtin_bit_cast(v4i_t, a), y = __builtin_bit_cast(v4i_t, b); return __builtin_shufflevector(x, y, 0, 1, 2, 3, 4, 5, 6, 7); }
__device__ __forceinline__ bf16x8 lo8(const v8i_t x) { return __builtin_bit_cast(bf16x8, (v4i_t)__builtin_shufflevector(x, x, 0, 1, 2, 3)); }
__device__ __forceinline__ bf16x8 hi8(const v8i_t x) { return __builtin_bit_cast(bf16x8, (v4i_t)__builtin_shufflevector(x, x, 4, 5, 6, 7)); }
template <int Q> __device__ __forceinline__ f32x16 ins4(const f32x16 X, const f32x4 c) {
    const f32x16 w = __builtin_shufflevector(c, c, 0, 1, 2, 3, 0, 1, 2, 3, 0, 1, 2, 3, 0, 1, 2, 3);
    if constexpr (Q == 0) return __builtin_shufflevector(X, w, 16, 17, 18, 19, 4, 5, 6, 7, 8, 9, 10, 11, 12, 13, 14, 15);
    else if constexpr (Q == 1) return __builtin_shufflevector(X, w, 0, 1, 2, 3, 16, 17, 18, 19, 8, 9, 10, 11, 12, 13, 14, 15);
    else if constexpr (Q == 2) return __builtin_shufflevector(X, w, 0, 1, 2, 3, 4, 5, 6, 7, 16, 17, 18, 19, 12, 13, 14, 15);
    else return __builtin_shufflevector(X, w, 0, 1, 2, 3, 4, 5, 6, 7, 8, 9, 10, 11, 16, 17, 18, 19);
}
__device__ __forceinline__ void glds16_s(const char* sbase, const unsigned voff, const unsigned lds_dst) {
    unsigned keep;
    asm volatile("s_mov_b32 %0, m0\n\ts_mov_b32 m0, %3\n\ts_nop 0\n\tglobal_load_lds_dwordx4 %1, %2\n\ts_mov_b32 m0, %0" : "=&s"(keep) : "v"(voff), "s"(sbase), "s"(lds_dst) : "memory");
}
__device__ __forceinline__ void tile_order(int wgid, int nM, int nN, int& pm, int& pn) {
    const int nwg = nM * nN; { const int q = nwg / NXCD, r = nwg % NXCD, xcd = wgid % NXCD, off = wgid / NXCD; wgid = (xcd < r ? xcd * (q + 1) : r * (q + 1) + (xcd - r) * q) + off; }
    const int nig = WGM * nN, gid = wgid / nig, fm = gid * WGM, gsz = (nM - fm) < WGM ? (nM - fm) : WGM;
    pm = fm + ((wgid % nig) % gsz); pn = (wgid % nig) / gsz;
}

struct NoMid { };
template <class T, class = void> struct EpiHasPf { static constexpr bool v = false; };
template <class T> struct EpiHasPf<T, decltype((void)T::HAS_PF)> { static constexpr bool v = true; };
constexpr int EPF_OFF = RING_BYTES;
template <class Epi, class Sched, bool GATHER, bool FP8 = false, bool ATILED = false, bool CADJ = false, class Mid = NoMid>
__device__ __forceinline__ void gemm_phase(LAS unsigned char* lds, const int wid, const int lda, const int ldb, const int K, const Sched& S, const Epi& E, const Mid& MH = Mid{}) {
    const int lane = fresh_lane(), tid = wid * 64 + lane, wr = wid >> 2, wc = wid & 3, fr = lane & 15, fq = lane >> 4;
    const int nt = K / BK;
    unsigned vA0[2], vA1[2], voffB[2];
#pragma unroll
    for (int i = 0; i < 2; ++i) { int R, C; stage_rc(tid * 16 + i * 8192, R, C); const int Rb = (R & ~31) + perm32(R & 31);
        if constexpr (ATILED) { vA0[i] = (unsigned)((C >> 3) * 4096 + R * 16); vA1[i] = vA0[i] + 2048u; }
        else { vA0[i] = (unsigned)(R * lda + C) * 2u; vA1[i] = vA0[i] + (unsigned)(HALF * lda) * 2u; }
        if constexpr (CADJ) voffB[i] = (unsigned)((64 * ((Rb >> 5) & 3) + 16 * ((Rb >> 3) & 3) + (Rb & 7)) * ldb + C) * 2u; else voffB[i] = (unsigned)(Rb * ldb + C) * 2u; }
    const size_t kstep = (size_t)(BK * 2), kstepA = ATILED ? (size_t)32768 : kstep;
    const size_t hstepB = CADJ ? (size_t)8 * ldb * 2 : (size_t)HALF * ldb * 2;
    const unsigned ldsw = (unsigned)wid * 1024u;
    const int aoff = lds_byte(wr * 64 + fr, fq * 8), boff = lds_byte(wc * 32 + fr, fq * 8);
#define PG8_SA(b, h) (((b) * 2 + (h)) * HTB)
#define PG8_SB(b, h) ((4 + (b) * 2 + (h)) * HTB)
#define PG8_STAGE(bufoff, gbase, voff) do { _Pragma("unroll") for (int _i = 0; _i < 2; ++_i) \
        glds16_s((const char*)(gbase), (voff)[_i], (unsigned)(uintptr_t)(lds + (bufoff) + ldsw + _i * 8192)); } while (0)
#define PG8_LDA(dst, b, h) do { _Pragma("unroll") for (int m = 0; m < 4; ++m) dst[m] = cat8(*(const LAS bf16x8*)(lds + PG8_SA(b, h) + aoff + m * 2048), *(const LAS bf16x8*)(lds + PG8_SA(b, h) + aoff + m * 2048 + 1024)); } while (0)
#define PG8_LDB(dst, b, h) do { _Pragma("unroll") for (int n = 0; n < 2; ++n) dst[n] = cat8(*(const LAS bf16x8*)(lds + PG8_SB(b, h) + boff + n * 2048), *(const LAS bf16x8*)(lds + PG8_SB(b, h) + boff + n * 2048 + 1024)); } while (0)
#define PG8_Q(X, q) ((f32x4)__builtin_shufflevector(X, X, 4 * (q), 4 * (q) + 1, 4 * (q) + 2, 4 * (q) + 3))
#define PG8_MM1(X, q, m, n, At, Bt) do { f32x4 c_ = PG8_Q(X, q); \
        if constexpr (FP8) c_ = __builtin_amdgcn_mfma_scale_f32_16x16x128_f8f6f4(Bt[n], At[m], c_, 0, 0, 0, 0x7f7f7f7f, 0, 0x7f7f7f7f); \
        else { c_ = __builtin_amdgcn_mfma_f32_16x16x32_bf16(lo8(Bt[n]), lo8(At[m]), c_, 0, 0, 0); c_ = __builtin_amdgcn_mfma_f32_16x16x32_bf16(hi8(Bt[n]), hi8(At[m]), c_, 0, 0, 0); } \
        X = ins4<q>(X, c_); } while (0)
#define PG8_MMA(ai, bj, At, Bt) do { __builtin_amdgcn_s_setprio(1); \
        PG8_MM1(acc16[ai][bj][0], 0, 0, 0, At, Bt); PG8_MM1(acc16[ai][bj][0], 1, 0, 1, At, Bt); PG8_MM1(acc16[ai][bj][0], 2, 1, 0, At, Bt); PG8_MM1(acc16[ai][bj][0], 3, 1, 1, At, Bt); \
        PG8_MM1(acc16[ai][bj][1], 0, 2, 0, At, Bt); PG8_MM1(acc16[ai][bj][1], 1, 2, 1, At, Bt); PG8_MM1(acc16[ai][bj][1], 2, 3, 0, At, Bt); PG8_MM1(acc16[ai][bj][1], 3, 3, 1, At, Bt); \
        __builtin_amdgcn_s_setprio(0); } while (0)
#define PG8_WAIT_V(n) asm volatile("s_waitcnt vmcnt(" #n ")" ::: "memory")
#define PG8_WAIT_L(n) asm volatile("s_waitcnt lgkmcnt(" #n ")" ::: "memory")
#define PG8_BAR __builtin_amdgcn_s_barrier()
#define PG8_SCHED __builtin_amdgcn_sched_barrier(0)
#define PG8_GIDX(dst0, dst1, u) do { const int R0_ = (wid >> 1) * 16 + (lane >> 2); const unsigned Cb_ = (unsigned)(((wid & 1) * 32 + (((lane & 3) * 8) ^ (((lane >> 5) & 1) << 4))) * 2); \
        _Pragma("unroll") for (int _i = 0; _i < 2; ++_i) { dst0[_i] = (unsigned)(u).idx[R0_ + 64 * _i] * (unsigned)(lda * 2) + Cb_; dst1[_i] = (unsigned)(u).idx[HALF + R0_ + 64 * _i] * (unsigned)(lda * 2) + Cb_; } } while (0)
    GUnit cur, nxt; int ui = 0;
    if (!S.next(0, cur)) return;
    f32x16 acc16[2][2][2];
#define PG8_ZERO() do { _Pragma("unroll") for (int a = 0; a < 2; ++a) _Pragma("unroll") for (int b = 0; b < 2; ++b) _Pragma("unroll") for (int h = 0; h < 2; ++h) _Pragma("unroll") for (int r = 0; r < 16; ++r) acc16[a][b][h][r] = 0.f; } while (0)
    PG8_ZERO();
    v8i_t At[4], B0[2], B1[2];
    const char* cA = cur.A; const char* cB = cur.B;
    int pfs = 0;
    if constexpr (EpiHasPf<Epi>::v) { const float v0_ = E.pf_load(cur, tid, wid); ((LAS float*)(lds + EPF_OFF))[tid] = v0_; }
    if constexpr (GATHER) { PG8_GIDX(vA0, vA1, cur); VM_WAIT(); }
    PG8_STAGE(PG8_SB(0, 0), cB, voffB); PG8_STAGE(PG8_SB(0, 1), cB + hstepB, voffB); PG8_STAGE(PG8_SA(0, 0), cA, vA0); PG8_STAGE(PG8_SA(0, 1), cA, vA1);
    if (wr == 1) PG8_BAR;
    PG8_WAIT_V(2); PG8_BAR;
    PG8_STAGE(PG8_SB(1, 0), cB + kstep, voffB); PG8_STAGE(PG8_SA(1, 0), cA + kstepA, vA0); PG8_STAGE(PG8_SB(1, 1), cB + hstepB + kstep, voffB);
    PG8_WAIT_V(6); PG8_BAR;
    for (;;) {
        const bool has_next = S.next(ui + 1, nxt);
        const char* nA = has_next ? nxt.A : cA; const char* nB = has_next ? nxt.B : cB;
#pragma unroll 1
        for (int t = 0; t < nt; t += 2) {
            const bool last = (t == nt - 2);
            if constexpr (!__is_same(Mid, NoMid)) { if (t == (nt >> 1)) MH(acc16, cur, wr, wc, fr, fq); }
            const char* a1 = cA + (size_t)(t + 1) * kstepA;
            const char* a2 = last ? nA : cA + (size_t)(t + 2) * kstepA; const char* b2 = last ? nB : cB + (size_t)(t + 2) * kstep;
            const char* a3 = a2 + kstepA; const char* b3 = b2 + kstep;
            PG8_LDB(B0, 0, 0); PG8_LDB(B1, 0, 1); PG8_SCHED; PG8_LDA(At, 0, 0); PG8_STAGE(PG8_SA(1, 1), a1, vA1);
            if constexpr (GATHER) { if (last && has_next) PG8_GIDX(vA0, vA1, nxt); }
            PG8_WAIT_V(8); PG8_WAIT_L(0); PG8_BAR; PG8_MMA(0, 0, At, B0); PG8_MMA(0, 1, At, B1); PG8_BAR; PG8_SCHED;
            PG8_LDA(At, 0, 1); PG8_STAGE(PG8_SB(0, 0), b2, voffB); PG8_STAGE(PG8_SB(0, 1), b2 + hstepB, voffB); PG8_STAGE(PG8_SA(0, 0), a2, vA0);
            PG8_WAIT_V(8); PG8_WAIT_L(0); PG8_BAR; PG8_MMA(1, 0, At, B0); PG8_MMA(1, 1, At, B1); PG8_BAR; PG8_SCHED;
            PG8_LDB(B0, 1, 0); PG8_LDB(B1, 1, 1); PG8_SCHED; PG8_LDA(At, 1, 0); PG8_STAGE(PG8_SA(0, 1), a2, vA1);
            PG8_WAIT_V(8); PG8_WAIT_L(0); PG8_BAR; PG8_MMA(0, 0, At, B0); PG8_MMA(0, 1, At, B1); PG8_BAR; PG8_SCHED;
            PG8_LDA(At, 1, 1); PG8_STAGE(PG8_SB(1, 0), b3, voffB); PG8_STAGE(PG8_SB(1, 1), b3 + hstepB, voffB); PG8_STAGE(PG8_SA(1, 0), a3, vA0);
            PG8_WAIT_V(8); PG8_WAIT_L(0); PG8_BAR; PG8_MMA(1, 0, At, B0); PG8_MMA(1, 1, At, B1); PG8_BAR; PG8_SCHED;
        }
        float pfv = 0.f;
        if constexpr (EpiHasPf<Epi>::v) { if (has_next) pfv = E.pf_load_async(nxt, tid, wid); }
        if (wr == 0) PG8_BAR;
        { f32x4 acc[2][2][4][2];
#pragma unroll
          for (int a = 0; a < 2; ++a)
#pragma unroll
              for (int b = 0; b < 2; ++b)
#pragma unroll
                  for (int m = 0; m < 4; ++m)
#pragma unroll
                      for (int n = 0; n < 2; ++n)
#pragma unroll
                          for (int j = 0; j < 4; ++j) acc[a][b][m][n][j] = acc16[a][b][m >> 1][((m & 1) * 2 + n) * 4 + j];
          if constexpr (EpiHasPf<Epi>::v) E.run(acc, cur, wr, wc, fr, fq, (const LAS float*)(lds + EPF_OFF + pfs * 2048)); else E(acc, cur, wr, wc, fr, fq); }
        if constexpr (EpiHasPf<Epi>::v) { if (has_next) { E.pf_wait(pfv); ((LAS float*)(lds + EPF_OFF + (pfs ^ 1) * 2048))[tid] = pfv; pfs ^= 1; } }
        if (!has_next) break;
        PG8_ZERO();
        cur = nxt; cA = nA; cB = nB; ++ui;
        if (wr == 1) PG8_BAR;
    }
    PG8_WAIT_V(0);
    PG8_BAR;
#undef PG8_SA
#undef PG8_SB
#undef PG8_STAGE
#undef PG8_LDA
#undef PG8_LDB
#undef PG8_MMA
#undef PG8_WAIT_V
#undef PG8_WAIT_L
#undef PG8_BAR
#undef PG8_SCHED
#undef PG8_GIDX
#undef PG8_ZERO
#undef PG8_Q
#undef PG8_MM1
}
}
using pg8::GUnit;
enum { K_Q = 0, K_K = 1, K_U = 2, K_GA = 3, K_GS = 4, K_VT = 5, K_XK = 6, K_XVT = 7 };
typedef f32x4 Acc[2][2][4][2];

__device__ __forceinline__ u32x4 pack8(const f32x4 a, const f32x4 b) { u32x4 w; w.x = cvt_pk_bf16(a[0], a[1]); w.y = cvt_pk_bf16(a[2], a[3]); w.z = cvt_pk_bf16(b[0], b[1]); w.w = cvt_pk_bf16(b[2], b[3]); return w; }
__device__ __forceinline__ void unpack8(const u32x4 w, f32x4& a, f32x4& b) { a = (f32x4){bf_lo(w.x), bf_hi(w.x), bf_lo(w.y), bf_hi(w.y)}; b = (f32x4){bf_lo(w.z), bf_hi(w.z), bf_lo(w.w), bf_hi(w.w)}; }
__device__ __forceinline__ f32x4 sig4(const f32x4 v) { return (f32x4){fast_sigmoid(v[0]), fast_sigmoid(v[1]), fast_sigmoid(v[2]), fast_sigmoid(v[3])}; }
__device__ __forceinline__ void store_pair16(bf16_t* blk, const size_t ld, const u32x4 c0, const u32x4 c1, const int k0, const int k1, const int fr) {
    u32x4 r1, dA, dB; const bool lo = fr < 8;
#pragma unroll
    for (int k = 0; k < 4; ++k) { r1[k] = (unsigned)__builtin_amdgcn_update_dpp(0, (int)c1[k], 0x128  , 0xF, 0xF, false); dA[k] = lo ? c0[k] : r1[k]; dB[k] = lo ? r1[k] : c0[k]; }
    *(u32x4*)(blk + (size_t)(fr & 7) * ld + (lo ? k0 : k1) * 8) = dA;
    *(u32x4*)(blk + (size_t)(8 + (fr & 7)) * ld + (lo ? k1 : k0) * 8) = dB;
}
__device__ __forceinline__ float row_rstd16(const float* ssp, int row) {
    const f32x4* p = (const f32x4*)(ssp + (size_t)row * 16); const f32x4 a = p[0], b = p[1], c = p[2], d = p[3];
    const float s = ((a[0] + a[1]) + (a[2] + a[3])) + ((b[0] + b[1]) + (b[2] + b[3])) + ((c[0] + c[1]) + (c[2] + c[3])) + ((d[0] + d[1]) + (d[2] + d[3]));
    return __builtin_amdgcn_rsqf(s * (1.0f / DM) + EPS);
}

struct EpiP1 {
    unsigned char* ws; const float* rstd0; const float* rope;
    __device__ __forceinline__ void operator()(const Acc& acc, const GUnit& u, int wr, int wc, int fr, int fq) const {
        const int kind = u.kind, row0 = u.pm * 256 + wr * 64 + fr;
        if (kind <= K_K) {
            bf16_t* O = (bf16_t*)(ws + ((kind == K_Q) ? WS_Q : WS_K)); const float sc = (kind == K_Q) ? QSCALE : 1.0f;
            const int cb = (u.pn & 1) * 256 + wc * 64 + fq * 8;
#pragma unroll
            for (int ai = 0; ai < 2; ++ai) {
                float rsv[4]; f32x4 rq[4][4];
#pragma unroll
                for (int m = 0; m < 4; ++m) { const int row = row0 + ai * 128 + m * 16; rsv[m] = rstd0[row];
                    const f32x4* rp = (const f32x4*)(rope + ((size_t)(row & (SEQ - 1)) * 32 + fq * 8) * 2); rq[m][0] = rp[0]; rq[m][1] = rp[1]; rq[m][2] = rp[2]; rq[m][3] = rp[3]; }
                __builtin_amdgcn_sched_barrier(0);
#pragma unroll
                for (int m = 0; m < 4; ++m) {
                    const int row = row0 + ai * 128 + m * 16; const float rs = rsv[m] * sc;
                    const f32x4 r0 = rq[m][0], r1 = rq[m][1], r2 = rq[m][2], r3 = rq[m][3];
                    const f32x4 a0 = acc[ai][0][m][0] * rs, a1 = acc[ai][0][m][1] * rs, b0 = acc[ai][1][m][0] * rs, b1 = acc[ai][1][m][1] * rs;
                    const f32x4 c0 = (f32x4){r0[0], r0[2], r1[0], r1[2]}, s0 = (f32x4){r0[1], r0[3], r1[1], r1[3]}, c1 = (f32x4){r2[0], r2[2], r3[0], r3[2]}, s1 = (f32x4){r2[1], r2[3], r3[1], r3[3]};
                    const f32x4 o1a = a0 * c0 - b0 * s0, o1b = a1 * c1 - b1 * s1, o2a = b0 * c0 + a0 * s0, o2b = b1 * c1 + a1 * s1;
                    store_pair16(O + (size_t)(row - fr) * 512 + (u.pn & 1) * 256 + wc * 64, 512, pack8(o1a, o1b), pack8(o2a, o2b), fq, 4 + fq, fr);
                }
            }
        } else if (kind <= K_GS) {
            int cb, ld; size_t wo;
            if (kind == K_U) { wo = WS_U; cb = (u.pn - 4) * 256; ld = 512; } else if (kind == K_GA) { wo = WS_GA; cb = (u.pn - 6) * 256; ld = 1024; } else { wo = WS_GS; cb = (u.pn - 10) * 256; ld = 1024; }
            bf16_t* O = (bf16_t*)(ws + wo);
            cb += wc * 64;
            float rsv[8];
#pragma unroll
            for (int i = 0; i < 8; ++i) rsv[i] = rstd0[row0 + (i >> 2) * 128 + (i & 3) * 16];
            __builtin_amdgcn_sched_barrier(0);
#pragma unroll
            for (int ai = 0; ai < 2; ++ai)
#pragma unroll
                for (int m = 0; m < 4; ++m) {
                    const int row = row0 + ai * 128 + m * 16; const float rs = rsv[ai * 4 + m]; u32x4 ch[2];
#pragma unroll
                    for (int bj = 0; bj < 2; ++bj) {
                        f32x4 v0 = acc[ai][bj][m][0] * rs, v1 = acc[ai][bj][m][1] * rs;
                        if (kind != K_U) { v0 = sig4(v0); v1 = sig4(v1); }
                        ch[bj] = pack8(v0, v1);
                    }
                    store_pair16(O + (size_t)(row - fr) * ld + cb, ld, ch[0], ch[1], 2 * fq, 2 * fq + 1, fr);
                }
        } else {
            bf16_t* O = (bf16_t*)(ws + ((kind == K_VT) ? WS_VT : (kind == K_XK ? WS_XK : WS_XVT))); const int ld = (kind == K_VT) ? NTOK : (kind == K_XK ? 1024 : NMEMTOK);
            const int cb = u.pn * 256 + wc * 64 + fq * 16;
            f32x4 cs[2][2];
#pragma unroll
            for (int bj = 0; bj < 2; ++bj) { if (kind == K_VT) { cs[bj][0] = *(const f32x4*)(rstd0 + cb + bj * 8); cs[bj][1] = *(const f32x4*)(rstd0 + cb + bj * 8 + 4); } else { cs[bj][0] = (f32x4){1.f, 1.f, 1.f, 1.f}; cs[bj][1] = cs[bj][0]; } }
#pragma unroll
            for (int ai = 0; ai < 2; ++ai)
#pragma unroll
                for (int m = 0; m < 4; ++m) {
                    const int row = row0 + ai * 128 + m * 16;
                    store_pair16(O + (size_t)(row - fr) * ld + u.pn * 256 + wc * 64, ld, pack8(acc[ai][0][m][0] * cs[0][0], acc[ai][0][m][1] * cs[0][1]), pack8(acc[ai][1][m][0] * cs[1][0], acc[ai][1][m][1] * cs[1][1]), 2 * fq, 2 * fq + 1, fr);
                }
        }
    }
};
struct EpiGlu {
    bf16_t* OAS;
    __device__ __forceinline__ void operator()(const Acc& acc, const GUnit& u, int wr, int wc, int fr, int fq) const {
        const int row0 = u.pm * 256 + wr * 64 + fr, cb = 512 + u.pn * 128 + wc * 32 + fq * 8;
#pragma unroll
        for (int ai = 0; ai < 2; ++ai)
#pragma unroll
            for (int m = 0; m < 4; ++m) { const int row = row0 + ai * 128 + m * 16;
                *(u32x4*)(OAS + (size_t)row * 1024 + cb) = pack8(acc[ai][0][m][0] * sig4(acc[ai][1][m][0]), acc[ai][0][m][1] * sig4(acc[ai][1][m][1])); }
    }
};
#ifndef PROBE_PITCH
#define PROBE_PITCH 1024
#endif
template <int MODE> struct EpiProbe {
    bf16_t* OAS;
    __device__ __forceinline__ void operator()(const Acc& acc, const GUnit& u, int wr, int wc, int fr, int fq) const {
        const int row0 = u.pm * 256 + wr * 64 + fr, cb = 512 + u.pn * 128 + wc * 32 + fq * 8;
        if (MODE == 3) {
#pragma unroll
            for (int ai = 0; ai < 2; ++ai)
#pragma unroll
                for (int m = 0; m < 4; ++m)
#pragma unroll
                    for (int hh = 0; hh < 2; ++hh) { const int row = u.pm * 256 + wr * 64 + ai * 128 + m * 16 + hh * 8 + (fr & 7), cc = 512 + u.pn * 128 + ((wc >> 1) * 64) + (fq * 2 + (fr >> 3)) * 8;
                        if ((wc & 1) == hh) *(u32x4*)(OAS + (size_t)row * PROBE_PITCH + cc) = pack8(acc[ai][0][m][0] + acc[ai][1][m][0], acc[ai][0][m][1] + acc[ai][1][m][1]); }
        } else if (MODE == 1) {
#pragma unroll
            for (int ai = 0; ai < 2; ++ai)
#pragma unroll
                for (int m = 0; m < 4; ++m) { const int row = row0 + ai * 128 + m * 16;
                    *(u32x4*)(OAS + (size_t)row * PROBE_PITCH + cb) = pack8(acc[ai][0][m][0] + acc[ai][1][m][0], acc[ai][0][m][1] + acc[ai][1][m][1]); }
        } else { f32x4 s = (f32x4){0.f, 0.f, 0.f, 0.f};
#pragma unroll
            for (int ai = 0; ai < 2; ++ai)
#pragma unroll
                for (int bj = 0; bj < 2; ++bj)
#pragma unroll
                    for (int m = 0; m < 4; ++m) s += acc[ai][bj][m][0] + acc[ai][bj][m][1];
            if (s[0] + s[1] + s[2] + s[3] == 123456.789f) OAS[(size_t)row0 * 1024 + cb] = 1; }
    }
};
template <int MODE> struct EpiBranch {
    const bf16_t* G; const bf16_t* P; bf16_t* O;
    __device__ __forceinline__ void operator()(const Acc& acc, const GUnit& u, int wr, int wc, int fr, int fq) const {
        const int row0 = u.pm * 256 + wr * 64 + fr, cb = u.pn * 256 + wc * 64 + fq * 16;
#pragma unroll
        for (int ai = 0; ai < 2; ++ai) {
            u32x4 gw[4][2], pw[4][2];
#pragma unroll
            for (int m = 0; m < 4; ++m)
#pragma unroll
                for (int bj = 0; bj < 2; ++bj) { const size_t off = (size_t)(row0 + ai * 128 + m * 16) * 1024 + cb + bj * 8; gw[m][bj] = *(const u32x4*)(G + off); if (MODE == 1) pw[m][bj] = *(const u32x4*)(P + off); }
            __builtin_amdgcn_sched_barrier(0);
#pragma unroll
            for (int m = 0; m < 4; ++m) { u32x4 ch[2];
#pragma unroll
                for (int bj = 0; bj < 2; ++bj) { f32x4 g0, g1; unpack8(gw[m][bj], g0, g1);
                    f32x4 v0 = g0 * acc[ai][bj][m][0], v1 = g1 * acc[ai][bj][m][1];
                    if (MODE == 1) { f32x4 p0, p1; unpack8(pw[m][bj], p0, p1); v0 += p0; v1 += p1; }
                    ch[bj] = pack8(v0, v1); }
                store_pair16(O + (size_t)(row0 - fr + ai * 128 + m * 16) * 1024 + u.pn * 256 + wc * 64, 1024, ch[0], ch[1], 2 * fq, 2 * fq + 1, fr); }
        }
    }
};
constexpr float GATE_TINY = 9.094947017729282e-13f;
template <int MCH> struct MidGateT {
    const bf16_t* GA; const bf16_t* GS;
    __device__ __forceinline__ void operator()(f32x16 (&acc16)[2][2][2], const GUnit& u, int wr, int wc, int fr, int fq) const {
        const unsigned vo = (unsigned)((u.pm * 256 + wr * 64 + fr) * 1024 + u.pn * 256 + wc * 64 + fq * 16) * 2u;
        const char* ga_ = (const char*)GA; const char* gs_ = (const char*)GS;
#pragma unroll
        for (int ai = 0; ai < 2; ++ai)
#pragma unroll
            for (int mc = 0; mc < 4; mc += MCH) { u32x4 ga[MCH][2], gs[MCH][2];
                unsigned vq = vo + (unsigned)((ai * 128 + mc * 16) * 2048); asm volatile("" : "+v"(vq));
#pragma unroll
                for (int mm = 0; mm < MCH; ++mm)
#pragma unroll
                    for (int bj = 0; bj < 2; ++bj) { const unsigned off = vq + (unsigned)(mm * 16 * 2048 + bj * 16); ga[mm][bj] = *(const u32x4*)(ga_ + off); gs[mm][bj] = *(const u32x4*)(gs_ + off); }
                __builtin_amdgcn_sched_barrier(0);
#pragma unroll
                for (int mm = 0; mm < MCH; ++mm) { const int m = mc + mm;
#pragma unroll
                    for (int bj = 0; bj < 2; ++bj) { f32x4 g0, g1, s0, s1; unpack8(ga[mm][bj], g0, g1); unpack8(gs[mm][bj], s0, s1);
#pragma unroll
                        for (int j = 0; j < 4; ++j) { acc16[ai][bj][m >> 1][((m & 1) * 2 + 0) * 4 + j] *= g0[j] * __builtin_amdgcn_rcpf(fmaxf(s0[j], GATE_TINY)); acc16[ai][bj][m >> 1][((m & 1) * 2 + 1) * 4 + j] *= g1[j] * __builtin_amdgcn_rcpf(fmaxf(s1[j], GATE_TINY)); } } }
                __builtin_amdgcn_sched_barrier(0);
            }
    }
};
#ifndef MID_MCH
#define MID_MCH 4
#endif
typedef MidGateT<MID_MCH> MidGate;
struct EpiGateOut {
    const bf16_t* GS; bf16_t* O;
    __device__ __forceinline__ void operator()(const Acc& acc, const GUnit& u, int wr, int wc, int fr, int fq) const {
        const int row0 = u.pm * 256 + wr * 64 + fr, cb = u.pn * 256 + wc * 64 + fq * 16;
        u32x4 gw[2][4][2];
#pragma unroll
        for (int ai = 0; ai < 2; ++ai)
#pragma unroll
            for (int m = 0; m < 4; ++m)
#pragma unroll
                for (int bj = 0; bj < 2; ++bj) gw[ai][m][bj] = *(const u32x4*)(GS + (size_t)(row0 + ai * 128 + m * 16) * 1024 + cb + bj * 8);
        __builtin_amdgcn_sched_barrier(0);
#pragma unroll
        for (int ai = 0; ai < 2; ++ai) {
#pragma unroll
            for (int m = 0; m < 4; ++m) { u32x4 ch[2];
#pragma unroll
                for (int bj = 0; bj < 2; ++bj) { f32x4 g0, g1; unpack8(gw[ai][m][bj], g0, g1);
#pragma unroll
                    for (int j = 0; j < 4; ++j) { g0[j] = fmaxf(g0[j], GATE_TINY); g1[j] = fmaxf(g1[j], GATE_TINY); }
                    ch[bj] = pack8(g0 * acc[ai][bj][m][0], g1 * acc[ai][bj][m][1]); }
                store_pair16(O + (size_t)(row0 - fr + ai * 128 + m * 16) * 1024 + u.pn * 256 + wc * 64, 1024, ch[0], ch[1], 2 * fq, 2 * fq + 1, fr); }
        }
    }
};
template <bool BASE_F32, bool WITH8 = !BASE_F32> struct EpiResid {
    const void* base; bf16_t* O; float* ssp; unsigned char* O8;
    static_assert(!BASE_F32, "the residual base is a bf16 tensor");
    __device__ __forceinline__ void operator()(const Acc& acc, const GUnit& u, int wr, int wc, int fr, int fq) const {
        const int row0 = u.pm * 256 + wr * 64 + fr, cb = u.pn * 256 + wc * 64 + fq * 16;
        u32x4 bw[2][4][2];
#pragma unroll
        for (int ai = 0; ai < 2; ++ai)
#pragma unroll
            for (int m = 0; m < 4; ++m)
#pragma unroll
                for (int bj = 0; bj < 2; ++bj) bw[ai][m][bj] = *(const u32x4*)((const bf16_t*)base + (size_t)(row0 + ai * 128 + m * 16) * 1024 + cb + bj * 8);
        __builtin_amdgcn_sched_barrier(0);
#pragma unroll
        for (int ai = 0; ai < 2; ++ai) {
#pragma unroll
            for (int m = 0; m < 4; ++m) { const int row = row0 + ai * 128 + m * 16; const size_t off = (size_t)row * 1024 + cb; float s = 0.f; u32x4 ch[2];
#pragma unroll
                for (int bj = 0; bj < 2; ++bj) { f32x4 b0, b1; unpack8(bw[ai][m][bj], b0, b1);
                    const f32x4 v0 = b0 + acc[ai][bj][m][0], v1 = b1 + acc[ai][bj][m][1];
                    s += (v0[0] * v0[0] + v0[1] * v0[1]) + (v0[2] * v0[2] + v0[3] * v0[3]) + (v1[0] * v1[0] + v1[1] * v1[1]) + (v1[2] * v1[2] + v1[3] * v1[3]);
                    ch[bj] = pack8(v0, v1);
                    if (WITH8) *(u32x2*)(O8 + off + bj * 8) = (u32x2){pack4_fp8(v0[0], v0[1], v0[2], v0[3]), pack4_fp8(v1[0], v1[1], v1[2], v1[3])}; }
                store_pair16(O + (size_t)(row - fr) * 1024 + u.pn * 256 + wc * 64, 1024, ch[0], ch[1], 2 * fq, 2 * fq + 1, fr);
                s += __shfl_xor(s, 16); s += __shfl_xor(s, 32);
                if (fq == 0) ssp[(size_t)row * 16 + u.pn * 4 + wc] = s; }
        }
    }
};
struct EpiXq {
    bf16_t* O; const float* ssp;
    __device__ __forceinline__ void operator()(const Acc& acc, const GUnit& u, int wr, int wc, int fr, int fq) const {
        const int row0 = u.pm * 256 + wr * 64 + fr;
#pragma unroll
        for (int ai = 0; ai < 2; ++ai) {
            f32x4 sp[4][4];
#pragma unroll
            for (int m = 0; m < 4; ++m) { const f32x4* p = (const f32x4*)(ssp + (size_t)(row0 + ai * 128 + m * 16) * 16); sp[m][0] = p[0]; sp[m][1] = p[1]; sp[m][2] = p[2]; sp[m][3] = p[3]; }
            __builtin_amdgcn_sched_barrier(0);
#pragma unroll
            for (int m = 0; m < 4; ++m) { const int row = row0 + ai * 128 + m * 16; const f32x4 a = sp[m][0], b = sp[m][1], c = sp[m][2], d = sp[m][3];
                const float sm = ((a[0] + a[1]) + (a[2] + a[3])) + ((b[0] + b[1]) + (b[2] + b[3])) + ((c[0] + c[1]) + (c[2] + c[3])) + ((d[0] + d[1]) + (d[2] + d[3]));
                const float rs = __builtin_amdgcn_rsqf(sm * (1.0f / DM) + EPS) * XQSCALE;
                store_pair16(O + (size_t)(row - fr) * 1024 + u.pn * 256 + wc * 64, 1024, pack8(acc[ai][0][m][0] * rs, acc[ai][0][m][1] * rs), pack8(acc[ai][1][m][0] * rs, acc[ai][1][m][1] * rs), 2 * fq, 2 * fq + 1, fr); }
        }
    }
};
struct EpiE1 {
    unsigned char* ACT; const float* rscale; const float* b1;
    __device__ __forceinline__ void operator()(const Acc& acc, const GUnit& u, int wr, int wc, int fr, int fq) const {
        const int row0 = u.pm * 256 + wr * 64 + fr, cc = u.pn * 128 + wc * 32 + fq * 8; const float* bb = b1 + (size_t)u.e * 2048 + cc;
        const f32x4 bg0 = *(const f32x4*)bb, bg1 = *(const f32x4*)(bb + 4), bl0 = *(const f32x4*)(bb + 1024), bl1 = *(const f32x4*)(bb + 1028);
        unsigned char* abase = ACT + (size_t)u.pm * 262144 + u.pn * 32768; const unsigned alo = (unsigned)((2 * wc + (fq >> 1)) * 4096 + (fq & 1) * 8 + (wr * 64 + fr) * 16);
        float rsv[8];
#pragma unroll
        for (int i = 0; i < 8; ++i) rsv[i] = rscale[u.kind + wr * 64 + fr + (i >> 2) * 128 + (i & 3) * 16] * W8INV;
        constexpr float KS = 1.702f * LOG2E, KI = 1.0f / KS;
        const f32x4 bgk0 = bg0 * -KS, bgk1 = bg1 * -KS, blk0 = (bl0 + 1.0f) * -KI, blk1 = (bl1 + 1.0f) * -KI;
        __builtin_amdgcn_sched_barrier(0);
#pragma unroll
        for (int ai = 0; ai < 2; ++ai)
#pragma unroll
            for (int m = 0; m < 4; ++m) { const float rs = rsv[ai * 4 + m], rsg = rs * -KS, rsl = rs * -KI;
                f32x4 g0 = acc[ai][0][m][0] * rsg + bgk0, g1 = acc[ai][0][m][1] * rsg + bgk1, l0 = acc[ai][1][m][0] * rsl + blk0, l1 = acc[ai][1][m][1] * rsl + blk1, d0, d1, o0, o1;
#pragma unroll
                for (int j = 0; j < 4; ++j) { g0[j] = fmaxf(g0[j], -7.0f * KS); g1[j] = fmaxf(g1[j], -7.0f * KS); l0[j] = fminf(fmaxf(l0[j], -8.0f * KI), 6.0f * KI); l1[j] = fminf(fmaxf(l1[j], -8.0f * KI), 6.0f * KI);
                    d0[j] = __builtin_amdgcn_exp2f(g0[j]); d1[j] = __builtin_amdgcn_exp2f(g1[j]); }
                d0 = d0 + 1.0f; d1 = d1 + 1.0f; g0 = g0 * l0; g1 = g1 * l1;
#pragma unroll
                for (int j = 0; j < 4; ++j) { d0[j] = __builtin_amdgcn_rcpf(d0[j]); d1[j] = __builtin_amdgcn_rcpf(d1[j]); }
                o0 = g0 * d0; o1 = g1 * d1;
                *(u32x2*)(abase + alo + (unsigned)((ai * 128 + m * 16) * 16)) = (u32x2){pack4_fp8(o0[0], o0[1], o0[2], o0[3]), pack4_fp8(o1[0], o1[1], o1[2], o1[3])}; }
    }
};
__device__ __forceinline__ float pf_ld32(const float* base, const unsigned voff) { float v; asm volatile("global_load_dword %0, %1, %2" : "=v"(v) : "v"(voff), "s"(base) : "memory"); return v; }
struct EpiE2 {
    unsigned char* YS; const float* roww; const float* b2;
    static constexpr bool HAS_PF = true;
    __device__ __forceinline__ unsigned pf_off(const GUnit& u, const int tid) const { return (unsigned)(tid < 256 ? u.kind + tid : u.e * 1024 + u.pn * 256 + (tid - 256)) * 4u; }
    __device__ __forceinline__ float pf_load(const GUnit& u, const int tid, const int wid) const { return *(const float*)((const char*)(wid < 4 ? roww : b2) + pf_off(u, tid)); }
    __device__ __forceinline__ float pf_load_async(const GUnit& u, const int tid, const int wid) const { return pf_ld32(wid < 4 ? roww : b2, pf_off(u, tid)); }
    __device__ __forceinline__ void pf_wait(float& v) const { asm volatile("s_waitcnt vmcnt(8)" : "+v"(v) :: "memory"); }
    __device__ __forceinline__ void run(const Acc& acc, const GUnit& u, int wr, int wc, int fr, int fq, const LAS float* pf) const {
        const int row0 = u.pm * 256 + wr * 64 + fr, cb = u.pn * 256 + wc * 64 + fq * 16;
        f32x4 bv[2][2];
#pragma unroll
        for (int bj = 0; bj < 2; ++bj) { bv[bj][0] = *(const LAS f32x4*)(pf + 256 + wc * 64 + fq * 16 + bj * 8); bv[bj][1] = *(const LAS f32x4*)(pf + 256 + wc * 64 + fq * 16 + bj * 8 + 4); }
        float wv[8];
#pragma unroll
        for (int i = 0; i < 8; ++i) wv[i] = pf[wr * 64 + fr + (i >> 2) * 128 + (i & 3) * 16];
#pragma unroll
        for (int ai = 0; ai < 2; ++ai)
#pragma unroll
            for (int m = 0; m < 4; ++m) { const int row = row0 + ai * 128 + m * 16; const float w = wv[ai * 4 + m]; u32x4 pk;
#pragma unroll
                for (int bj = 0; bj < 2; ++bj) { const f32x4 v0 = (acc[ai][bj][m][0] * W8INV + bv[bj][0]) * w, v1 = (acc[ai][bj][m][1] * W8INV + bv[bj][1]) * w;
                    pk[2 * bj] = pack4_fp8(v0[0], v0[1], v0[2], v0[3]); pk[2 * bj + 1] = pack4_fp8(v1[0], v1[1], v1[2], v1[3]); }
                *(u32x4*)(YS + (size_t)row * 1024 + cb) = pk; }
    }
};

struct SimpleSched {
    const char* A; const char* B; size_t strideA, strideB; int nM, nN, G, c;
    __device__ __forceinline__ bool next(int i, GUnit& u) const {
        const long L = (long)i * G + c; if (L >= (long)nM * nN) return false;
        int pm, pn; pg8::tile_order((int)L, nM, nN, pm, pn);
        u.pm = pm; u.pn = pn; u.kind = 0; u.e = 0; u.idx = nullptr; u.A = A + (size_t)pm * strideA; u.B = B + (size_t)pn * strideB; return true;
    }
};
struct OneUnitSched {
    SimpleSched S; int i0;
    __device__ __forceinline__ bool next(int i, GUnit& u) const { return i == 0 && S.next(i0, u); }
};
struct P1Sched {
    const char *XB, *WIN, *MEMN, *WXK, *WXV; int G, c;
    __device__ __forceinline__ bool next(int i, GUnit& u) const {
        long L = (long)i * G + c; constexpr size_t TS = 256 * 1024 * 2; u.e = 0; u.idx = nullptr;
        if (L < 1792) { int pm, pn; pg8::tile_order((int)L, 128, 14, pm, pn); u.pm = pm; u.pn = pn; u.A = XB + pm * TS; u.B = WIN + pn * TS;
            u.kind = pn < 2 ? K_Q : (pn < 4 ? K_K : (pn < 6 ? K_U : (pn < 10 ? K_GA : K_GS))); return true; }
        L -= 1792;
        if (L < 256) { u.pm = (int)(L >> 7); u.pn = (int)(L & 127); u.A = WIN + (size_t)(14 + u.pm) * TS; u.B = XB + u.pn * TS; u.kind = K_VT; return true; }
        L -= 256;
        if (G == 256) return false;
        if (L < 64) { u.pm = (int)(L >> 2); u.pn = (int)(L & 3); u.A = MEMN + u.pm * TS; u.B = WXK + u.pn * TS; u.kind = K_XK; return true; }
        L -= 64;
        if (L < 64) { u.pm = (int)(L >> 4); u.pn = (int)(L & 15); u.A = WXV + u.pm * TS; u.B = MEMN + u.pn * TS; u.kind = K_XVT; return true; }
        return false;
    }
};
struct CrossSched {
    const char *MEMN, *WXK, *WXV; int G, c;
    __device__ __forceinline__ bool next(int i, GUnit& u) const {
        if (G != 256 || i != 0 || c >= 128) return false;
        constexpr size_t TS = 256 * 1024 * 2; u.e = 0; u.idx = nullptr; int L = c;
        if (L < 64) { u.pm = L >> 2; u.pn = L & 3; u.A = MEMN + u.pm * TS; u.B = WXK + u.pn * TS; u.kind = K_XK; return true; }
        L -= 64; u.pm = L >> 4; u.pn = L & 15; u.A = WXV + u.pm * TS; u.B = MEMN + u.pn * TS; u.kind = K_XVT; return true;
    }
};
struct GluSched {
    SimpleSched S;
    __device__ __forceinline__ bool next(int i, GUnit& u) const {
        if (S.G != 256) return S.next(i, u);
        if (S.c < 128) { if (i != 0) return false; } else if (i >= 3) return false;
        SimpleSched T = S; T.G = 128; T.c = S.c & 127; return T.next(S.c < 128 ? 0 : i + 1, u);
    }
};
struct MoeSched {
    const char* A; const char* W; const int* rowtok; const LAS int* blk_e; int nblk, NTN, G, c; size_t wstride  ; bool gather;
    __device__ __forceinline__ bool next(int i, GUnit& u) const {
        const int nx = (G % 8 == 0) ? 8 : 1, x = c % nx, r = c / nx, Wx = G / nx;
        const int b0 = (nblk * x) / nx, b1 = (nblk * (x + 1)) / nx;
        const long L = (long)i * Wx + r; if (L >= (long)(b1 - b0) * NTN) return false;
        const int blk = b0 + (int)(L / NTN), pn = (int)(L % NTN), e = __builtin_amdgcn_readfirstlane(blk_e[blk]);
        const int rb = e * MOE_CAP + (blk - __builtin_amdgcn_readfirstlane(blk_e[720 + e])) * 256;
        u.pm = blk; u.pn = pn; u.kind = rb; u.e = e; u.idx = rowtok + rb;
        u.A = gather ? A : A + (size_t)blk * 256 * 1024; u.B = W + (size_t)e * wstride + (size_t)pn * 256 * 1024; return true;
    }
};
#ifndef DA_BAL
#define DA_BAL 1
#endif
#ifndef DA_PRIO_ON
#define DA_PRIO_ON 0
#endif
#if DA_PRIO_ON
#define DA_PRIO(x) __builtin_amdgcn_s_setprio(x)
#else
#define DA_PRIO(x) do { } while (0)
#endif
#define KSWZ(row, colB) ((row) * 256 + ((colB) ^ (((row) & 7) << 4)))
__device__ __forceinline__ int crow(int r, int hi) { return (r & 3) + 8 * (r >> 2) + 4 * hi; }
#define PK4(P, BASE, OUT) do { unsigned a0 = cvt_pk_bf16(P[BASE + 0], P[BASE + 1]), a1 = cvt_pk_bf16(P[BASE + 2], P[BASE + 3]);   \
    unsigned b0 = cvt_pk_bf16(P[BASE + 4], P[BASE + 5]), b1 = cvt_pk_bf16(P[BASE + 6], P[BASE + 7]);                              \
    auto r0 = __builtin_amdgcn_permlane32_swap(a0, b0, false, false); auto r1 = __builtin_amdgcn_permlane32_swap(a1, b1, false, false); \
    u32x4 w = {r0[0], r1[0], r0[1], r1[1]}; OUT = *reinterpret_cast<bf16x8*>(&w); } while (0)
__device__ __forceinline__ float half_max(float v) { auto rr = __builtin_amdgcn_permlane32_swap(__float_as_uint(v), __float_as_uint(v), false, false); return fmaxf(__uint_as_float(rr[0]), __uint_as_float(rr[1])); }
__device__ __forceinline__ float half_sum(float v) { auto rr = __builtin_amdgcn_permlane32_swap(__float_as_uint(v), __float_as_uint(v), false, false); return __uint_as_float(rr[0]) + __uint_as_float(rr[1]); }

constexpr int DA_NB = 4, DA_KT = 16384, DA_VT = 128 * 144, DA_K0 = 0, DA_V0 = DA_NB * DA_KT, DA_SCR = DA_V0 + DA_NB * DA_VT, DA_XCH = 0;
static_assert(DA_SCR + 8 * 256 <= PHASE_LDS && DA_XCH + 4 * 16384 <= DA_SCR, "diff-attn LDS");
constexpr float DA_THR = 11.5f;
__device__ __forceinline__ void da_partialSM(f32x16& p0, f32x16& p1, float& m_reg, float& alpha) {
    float pmax = p0[0];
#pragma unroll
    for (int r = 1; r < 16; ++r) pmax = fmaxf(pmax, p0[r]);
#pragma unroll
    for (int r = 0; r < 16; ++r) pmax = fmaxf(pmax, p1[r]);
    pmax = half_max(pmax);
    float mn;
    if (__builtin_expect(__all(pmax - m_reg <= DA_THR), 1)) { mn = m_reg; alpha = 1.f; }
    else { mn = fmaxf(m_reg, pmax); alpha = __builtin_amdgcn_exp2f(m_reg - mn); m_reg = mn; }
#pragma unroll
    for (int r = 0; r < 16; ++r) { p0[r] -= mn; p1[r] -= mn; }
#pragma unroll
    for (int r = 0; r < 16; ++r) p0[r] = __builtin_amdgcn_exp2f(p0[r]);
#if DA_BAL
#pragma unroll
    for (int r = 0; r < 16; ++r) p1[r] = __builtin_amdgcn_exp2f(p1[r]);
#endif
}
__device__ __forceinline__ void da_finishSM(f32x16& p0, f32x16& p1, const float alpha, float& l_reg, bf16x8& pa0, bf16x8& pa1, bf16x8& pa2, bf16x8& pa3) {
#if !DA_BAL
#pragma unroll
    for (int r = 0; r < 16; ++r) p1[r] = __builtin_amdgcn_exp2f(p1[r]);
#endif
    float ps = 0.f;
#pragma unroll
    for (int r = 0; r < 16; ++r) ps += p0[r];
#pragma unroll
    for (int r = 0; r < 16; ++r) ps += p1[r];
    ps = half_sum(ps);
    l_reg = l_reg * alpha + ps;
    PK4(p0, 0, pa0); PK4(p0, 8, pa1); PK4(p1, 0, pa2); PK4(p1, 8, pa3);
}
__device__ __forceinline__ void da_qkt(f32x16& p0, f32x16& p1, const LAS unsigned char* Ks, const bf16x8* qr, const int comp, const int r32, const int hi) {
#pragma unroll
    for (int r = 0; r < 16; ++r) { p0[r] = 0.f; p1[r] = 0.f; }
#pragma unroll
    for (int d0 = 0; d0 < 4; ++d0) { const int cb = (comp * 64 + d0 * 16 + hi * 8) * 2;
        const bf16x8 k0 = *(const LAS bf16x8*)(Ks + KSWZ(r32, cb)), k1 = *(const LAS bf16x8*)(Ks + KSWZ(32 + r32, cb));
        DA_PRIO(1);
        p0 = __builtin_amdgcn_mfma_f32_32x32x16_bf16(k0, qr[d0], p0, 0, 0, 0);
        p1 = __builtin_amdgcn_mfma_f32_32x32x16_bf16(k1, qr[d0], p1, 0, 0, 0);
        DA_PRIO(0); }
}
__device__ __forceinline__ void da_pv(f32x16* o, const LAS unsigned char* Vs, const bf16x8 pa0, const bf16x8 pa1, const bf16x8 pa2, const bf16x8 pa3, const int r32, const int hi) {
#pragma unroll
    for (int d0 = 0; d0 < 4; ++d0) { const LAS unsigned char* vp = Vs + (d0 * 32 + r32) * 144 + hi * 16;
        const bf16x8 v0 = *(const LAS bf16x8*)(vp), v1 = *(const LAS bf16x8*)(vp + 32), v2 = *(const LAS bf16x8*)(vp + 64), v3 = *(const LAS bf16x8*)(vp + 96);
        asm volatile("s_waitcnt lgkmcnt(0)" ::: "memory"); __builtin_amdgcn_sched_barrier(0);
        DA_PRIO(1);
        o[d0] = __builtin_amdgcn_mfma_f32_32x32x16_bf16(pa0, v0, o[d0], 0, 0, 0);
        o[d0] = __builtin_amdgcn_mfma_f32_32x32x16_bf16(pa1, v1, o[d0], 0, 0, 0);
        o[d0] = __builtin_amdgcn_mfma_f32_32x32x16_bf16(pa2, v2, o[d0], 0, 0, 0);
        o[d0] = __builtin_amdgcn_mfma_f32_32x32x16_bf16(pa3, v3, o[d0], 0, 0, 0);
        DA_PRIO(0); }
}
template <int VAR>
__device__ __forceinline__ void diff_attn_phase(LAS unsigned char* lds, const bf16_t* __restrict__ Q, const bf16_t* __restrict__ Kb, const bf16_t* __restrict__ VT, bf16_t* OAS,
                                                const float* subln_g, const float lam, const int G, const int c, const int wid) {
    const int lane = fresh_lane(), tid = wid * 64 + lane, r32 = lane & 31, hi = lane >> 5, comp = wid >> 2, w4 = wid & 3;
    LAS float* scr = (LAS float*)(lds + DA_SCR + wid * 256);
    constexpr int NT = SEQ / 64;
#define SBAR() __builtin_amdgcn_sched_barrier(0)
    for (int L = c; L < NBATCH * 4 * 16; L += G) {
        const int bh = L >> 4, qb = L & 15, b = bh >> 2, h = bh & 3;
        const size_t tok0 = (size_t)b * SEQ;
        bf16x8 qr[4];
        { const bf16_t* qp = Q + (tok0 + qb * 128 + w4 * 32 + r32) * 512 + h * 128 + comp * 64 + hi * 8;
#pragma unroll
          for (int d0 = 0; d0 < 4; ++d0) qr[d0] = *(const GAS bf16x8*)(qp + d0 * 16); }
        const bf16_t* kg = Kb + (tok0 + (tid >> 4)) * 512 + h * 128 + (tid & 15) * 8;
        const bf16_t* vg = VT + (size_t)(h * 128 + (tid >> 3)) * NTOK + tok0 + (tid & 7) * 8;
        const int kl0 = KSWZ((tid >> 4), (tid & 15) * 16), kl1 = KSWZ(32 + (tid >> 4), (tid & 15) * 16), vl0 = (tid >> 3) * 144 + (tid & 7) * 16, vl1 = vl0 + 64 * 144;
        bf16x8 ek0, ek1, ev0, ev1, fk0, fk1, fv0, fv1;
#define DA_LOAD(k0_, k1_, v0_, v1_, j) do { k0_ = *(const GAS bf16x8*)(kg + (size_t)(j) * 64 * 512); k1_ = *(const GAS bf16x8*)(kg + (size_t)((j) * 64 + 32) * 512); \
                        v0_ = *(const GAS bf16x8*)(vg + (j) * 64); v1_ = *(const GAS bf16x8*)(vg + (size_t)64 * NTOK + (j) * 64); } while (0)
#define DA_WRITE(bf, k0_, k1_, v0_, v1_) do { *(LAS bf16x8*)(lds + DA_K0 + (bf) * DA_KT + kl0) = k0_; *(LAS bf16x8*)(lds + DA_K0 + (bf) * DA_KT + kl1) = k1_; \
                          *(LAS bf16x8*)(lds + DA_V0 + (bf) * DA_VT + vl0) = v0_; *(LAS bf16x8*)(lds + DA_V0 + (bf) * DA_VT + vl1) = v1_; } while (0)
#define DA_SWAIT() asm volatile("s_waitcnt vmcnt(4)" ::: "memory")
#define DA_SYNC() do { if (VAR != 3) __syncthreads(); } while (0)
#define DA_RESC(a) do { if (__any((a) < 1.f)) { if (hi == 0) scr[r32] = (a); LDS_WAIT(); \
            _Pragma("unroll") for (int r = 0; r < 16; ++r) { const float a_ = scr[crow(r, hi)]; _Pragma("unroll") for (int d = 0; d < 4; ++d) o[d][r] *= a_; } } } while (0)
        float m_reg = -1e30f, l_reg = 0.f, al; f32x16 o[4], p0, p1; bf16x8 pa0, pa1, pa2, pa3;
#pragma unroll
        for (int d = 0; d < 4; ++d)
#pragma unroll
            for (int r = 0; r < 16; ++r) o[d][r] = 0.f;
#define DA_BAR() do { asm volatile("s_waitcnt lgkmcnt(0)" ::: "memory"); __builtin_amdgcn_s_barrier(); } while (0)
#define DA_KB(b) (lds + DA_K0 + (b) * DA_KT)
#define DA_VB(b) (lds + DA_V0 + (b) * DA_VT)
        DA_LOAD(ek0, ek1, ev0, ev1, 0); VM_WAIT(); DA_WRITE(0, ek0, ek1, ev0, ev1);
        DA_LOAD(ek0, ek1, ev0, ev1, 1); VM_WAIT(); DA_WRITE(1, ek0, ek1, ev0, ev1);
        DA_LOAD(ek0, ek1, ev0, ev1, 2);
        DA_BAR();
        if (comp == 1) DA_BAR();
#pragma unroll 1
        for (int t = 0; t < NT; t += 4) {
#pragma unroll
            for (int k = 0; k < 4; ++k) { const int u = t + k;
                SBAR(); da_qkt(p0, p1, DA_KB(k), qr, comp, r32, hi); da_partialSM(p0, p1, m_reg, al); SBAR();
                DA_BAR();
                da_finishSM(p0, p1, al, l_reg, pa0, pa1, pa2, pa3); DA_RESC(al); SBAR();
                if (u + 2 < NT) { VM_WAIT(); DA_WRITE((k + 2) & 3, ek0, ek1, ev0, ev1); }
                if (u + 3 < NT) DA_LOAD(ek0, ek1, ev0, ev1, u + 3);
                SBAR(); da_pv(o, DA_VB(k), pa0, pa1, pa2, pa3, r32, hi); SBAR();
                DA_BAR();
            }
        }
        if (comp == 0) DA_BAR();
#undef DA_BAR
#undef DA_KB
#undef DA_VB
        __syncthreads();
        if (hi == 0) scr[r32] = __builtin_amdgcn_rcpf(l_reg);
        LDS_WAIT();
#pragma unroll
        for (int r = 0; r < 16; ++r) { const float a = scr[crow(r, hi)];
#pragma unroll
            for (int d = 0; d < 4; ++d) o[d][r] *= a; }
        LAS float* xch = (LAS float*)(lds + DA_XCH + w4 * 16384);
        if (comp == 1) {
#pragma unroll
            for (int d = 0; d < 4; ++d)
#pragma unroll
                for (int r = 0; r < 16; ++r) xch[(d * 16 + r) * 64 + lane] = o[d][r];
        }
        __syncthreads();
        if (comp == 0) {
            float ssq[16];
#pragma unroll
            for (int r = 0; r < 16; ++r) ssq[r] = 0.f;
#pragma unroll
            for (int d = 0; d < 4; ++d)
#pragma unroll
                for (int r = 0; r < 16; ++r) { const float v = o[d][r] - lam * xch[(d * 16 + r) * 64 + lane]; o[d][r] = v; ssq[r] += v * v; }
#pragma unroll
            for (int r = 0; r < 16; ++r) {
                float s = ssq[r];
                s += __shfl_xor(s, 1); s += __shfl_xor(s, 2); s += __shfl_xor(s, 4); s += __shfl_xor(s, 8); s += __shfl_xor(s, 16);
                ssq[r] = __builtin_amdgcn_rsqf(s * (1.0f / 128.0f) + EPS) * (1.0f - LAMBDA_INIT);
            }
            const int lnb = fresh_lane(), r32b = lnb & 31, hib = lnb >> 5;
            bf16_t* op = OAS + (tok0 + qb * 128 + w4 * 32) * 1024 + h * 128 + r32b;
#pragma unroll
            for (int d = 0; d < 4; ++d) { const float g = subln_g[d * 32 + r32b];
#pragma unroll
                for (int r = 0; r < 16; ++r) { const float v = o[d][r] * ssq[r] * g; op[(size_t)crow(r, hib) * 1024 + d * 32] = (bf16_t)(cvt_pk_bf16(v, 0.f) & 0xffffu); } }
        }
        __syncthreads();
#undef DA_LOAD
#undef DA_WRITE
#undef DA_SWAIT
#undef DA_SYNC
#undef DA_RESC
    }
#undef SBAR
}

#define XSWZ(row, chunk) ((row) * 528 + (chunk) * 16)
constexpr int XA_BYTES = 256 * 528;
__device__ __forceinline__ void cross_attn_unit(LAS unsigned char* lds, const bf16_t* __restrict__ XQ, const bf16_t* __restrict__ XK, const bf16_t* __restrict__ XVT, bf16_t* XO, const int b, const int h, const int qb, const int wid) {
    const int lane = fresh_lane(), tid = wid * 64 + lane, r32 = lane & 31, hi = lane >> 5;
    LAS float* scr = (LAS float*)(lds + XA_BYTES + wid * 256);
    {
        { const bf16_t* src = XK + ((size_t)b * NMEM + (tid >> 5)) * 1024 + h * 256 + (tid & 31) * 8; LAS unsigned char* dst = lds + XSWZ(tid >> 5, tid & 31);
#pragma unroll 1
          for (int i0 = 0; i0 < 16; i0 += 8) { bf16x8 t[8];
#pragma unroll
            for (int i = 0; i < 8; ++i) t[i] = *(const bf16x8*)(src + (size_t)(i0 + i) * 16 * 1024);
#pragma unroll
            for (int i = 0; i < 8; ++i) *(LAS bf16x8*)(dst + (i0 + i) * 16 * 528) = t[i]; } }
        const bf16_t* qp = XQ + ((size_t)b * SEQ + qb * 256 + wid * 32 + r32) * 1024 + h * 256 + hi * 8;
        bf16x8 pa[16]; float linv;
        {
            f32x16 s[8];
#pragma unroll
            for (int kb = 0; kb < 8; ++kb)
#pragma unroll
                for (int r = 0; r < 16; ++r) s[kb][r] = 0.f;
            bf16x8 qa[2], qn[2];
#pragma unroll
            for (int i = 0; i < 2; ++i) qa[i] = *(const bf16x8*)(qp + i * 16);
            __syncthreads();
#pragma unroll
            for (int dg = 0; dg < 8; ++dg) {
                if (dg < 7) {
#pragma unroll
                    for (int i = 0; i < 2; ++i) qn[i] = *(const bf16x8*)(qp + (dg * 2 + 2 + i) * 16);
                }
                __builtin_amdgcn_sched_barrier(0);
#pragma unroll
                for (int i = 0; i < 2; ++i) { const int d0 = dg * 2 + i;
#pragma unroll
                    for (int kb = 0; kb < 8; ++kb) { const bf16x8 kf = *(const LAS bf16x8*)(lds + XSWZ(kb * 32 + r32, d0 * 2 + hi));
                        s[kb] = __builtin_amdgcn_mfma_f32_32x32x16_bf16(kf, qa[i], s[kb], 0, 0, 0); } }
                __builtin_amdgcn_sched_barrier(0);
#pragma unroll
                for (int i = 0; i < 2; ++i) qa[i] = qn[i];
            }
            float mx = s[0][0];
#pragma unroll
            for (int kb = 0; kb < 8; ++kb)
#pragma unroll
                for (int r = 0; r < 16; ++r) mx = fmaxf(mx, s[kb][r]);
            mx = half_max(mx);
            float ps = 0.f;
#pragma unroll
            for (int kb = 0; kb < 8; ++kb)
#pragma unroll
                for (int r = 0; r < 16; ++r) { s[kb][r] = __builtin_amdgcn_exp2f(s[kb][r] - mx); ps += s[kb][r]; }
            ps = half_sum(ps); linv = __builtin_amdgcn_rcpf(ps);
#pragma unroll
            for (int kb = 0; kb < 8; ++kb) { PK4(s[kb], 0, pa[2 * kb]); PK4(s[kb], 8, pa[2 * kb + 1]); }
        }
        __syncthreads();
        { const bf16_t* src = XVT + ((size_t)h * 256 + (tid >> 5)) * NMEMTOK + b * NMEM + (tid & 31) * 8; LAS unsigned char* dst = lds + XSWZ(tid >> 5, tid & 31);
#pragma unroll 1
          for (int i0 = 0; i0 < 16; i0 += 8) { bf16x8 t[8];
#pragma unroll
            for (int i = 0; i < 8; ++i) t[i] = *(const bf16x8*)(src + (size_t)(i0 + i) * 16 * NMEMTOK);
#pragma unroll
            for (int i = 0; i < 8; ++i) *(LAS bf16x8*)(dst + (i0 + i) * 16 * 528) = t[i]; } }
        if (hi == 0) scr[r32] = linv;
        __syncthreads();
        bf16_t* op = XO + ((size_t)b * SEQ + qb * 256 + wid * 32) * 1024 + h * 256 + r32;
#pragma unroll
        for (int cb = 0; cb < 8; ++cb) {
            f32x16 o;
#pragma unroll
            for (int r = 0; r < 16; ++r) o[r] = 0.f;
#pragma unroll
            for (int ks = 0; ks < 16; ++ks) { const bf16x8 vf = *(const LAS bf16x8*)(lds + XSWZ(cb * 32 + r32, ks * 2 + hi));
                o = __builtin_amdgcn_mfma_f32_32x32x16_bf16(pa[ks], vf, o, 0, 0, 0); }
#pragma unroll
            for (int r = 0; r < 16; ++r) { const float v = o[r] * scr[crow(r, hi)]; op[(size_t)crow(r, hi) * 1024 + cb * 32] = (bf16_t)(cvt_pk_bf16(v, 0.f) & 0xffffu); }
        }
        __syncthreads();
    }
}
constexpr int TP_PITCH = 136;
template <bool HAS_GAIN, class RowMap>
__device__ __forceinline__ void transpose_item(const float* __restrict__ W, const int K, const int N, bf16_t* WT, const float* gain, const RowMap& drow, LAS unsigned char* scr, const int item, const int lane, const int pitch = 0) {
    const int nblk = N / 64, kb = item / nblk, nb = item % nblk, k0 = kb * 64, n0 = nb * 64;
    const int nl = (lane & 15) * 4, kq = lane >> 4;
#pragma unroll
    for (int p = 0; p < 8; ++p) { const int kk = p * 8 + kq * 2;
        f32x4 a = *(const f32x4*)(W + (size_t)(k0 + kk) * N + n0 + nl), b = *(const f32x4*)(W + (size_t)(k0 + kk + 1) * N + n0 + nl);
        if (HAS_GAIN) { const float g0 = gain[k0 + kk], g1 = gain[k0 + kk + 1]; a = a * g0; b = b * g1; }
#pragma unroll
        for (int j = 0; j < 4; ++j) *(LAS unsigned*)(scr + (nl + j) * TP_PITCH + kk * 2) = cvt_pk_bf16(a[j], b[j]); }
    LDS_WAIT();
#pragma unroll
    for (int q = 0; q < 8; ++q) { const int n = q * 8 + (lane >> 3), ch = lane & 7;
        const u32x2 lo = *(const LAS u32x2*)(scr + n * TP_PITCH + ch * 16), hi = *(const LAS u32x2*)(scr + n * TP_PITCH + ch * 16 + 8);
        const int dr = drow(n0 + (n & ~7)) + (n & 7);
        *(u32x4*)(WT + (size_t)dr * (pitch ? pitch : K) + k0 + ch * 8) = (u32x4){lo.x, lo.y, hi.x, hi.y}; }
    LDS_WAIT();
}
template <class RowMap>
__device__ __forceinline__ void transpose_item_f8(const float* __restrict__ W, const int K, const int N, unsigned char* WT, const float* gain, const float scale, const RowMap& drow, LAS unsigned char* scr, const int item, const int lane) {
    const int nblk = N / 64, kb = item / nblk, nb = item % nblk, k0 = kb * 64, n0 = nb * 64;
    const int nl = (lane & 15) * 4, kq = lane >> 4;
#pragma unroll
    for (int p = 0; p < 4; ++p) { const int kk = p * 16 + kq * 4; f32x4 a[4];
#pragma unroll
        for (int r = 0; r < 4; ++r) { a[r] = *(const f32x4*)(W + (size_t)(k0 + kk + r) * N + n0 + nl); a[r] = a[r] * ((gain ? gain[k0 + kk + r] : 1.0f) * scale); }
#pragma unroll
        for (int j = 0; j < 4; ++j) *(LAS unsigned*)(scr + (nl + j) * 80 + kk) = pack4_fp8(a[0][j], a[1][j], a[2][j], a[3][j]); }
    LDS_WAIT();
#pragma unroll
    for (int q = 0; q < 4; ++q) { const int n = q * 16 + (lane >> 2), ch = lane & 3;
        const u32x4 v = *(const LAS u32x4*)(scr + n * 80 + ch * 16);
        const int dr = drow(n0 + (n & 32)) + (n & 31);
        *(u32x4*)(WT + (size_t)dr * K + k0 + ch * 16) = v; }
    LDS_WAIT();
}
struct ExpItem { const float* W; unsigned char* WT; const float* gain; int K, N, k0, n0, doff, is_e1; };
__device__ __forceinline__ ExpItem exp_item(const int it, const float* we1, const float* we2, const float* gffn, unsigned char* ws) {
    ExpItem x;
    if (it < 32 * 512) { const int e = it >> 9, r = it & 511; x.W = we1 + (size_t)e * 1024 * 2048; x.WT = ws + WS_WE1; x.gain = gffn; x.K = 1024; x.N = 2048; x.k0 = (r >> 6) * 128; x.n0 = (r & 63) * 32; x.doff = e * 2048; x.is_e1 = 1; }
    else { const int q = it - 32 * 512, e = q >> 8, r = q & 255; x.W = we2 + (size_t)e * 1024 * 1024; x.WT = ws + WS_WE2; x.gain = nullptr; x.K = 1024; x.N = 1024; x.k0 = (r >> 5) * 128; x.n0 = (r & 31) * 32; x.doff = e * 1024; x.is_e1 = 0; }
    return x;
}
__device__ __forceinline__ void exp_load(const ExpItem& x, f32x4 (&a)[4][4], const int lane) {
    const unsigned lane_off = (unsigned)(((lane >> 3) * 4 * x.N + (lane & 7) * 4) * 4);
#pragma unroll
    for (int p = 0; p < 4; ++p)
#pragma unroll
        for (int r = 0; r < 4; ++r) { const char* rowp = (const char*)(x.W + (size_t)(x.k0 + p * 32 + r) * x.N + x.n0); a[p][r] = *(const f32x4*)(rowp + lane_off); }
}
template <bool E1>
__device__ __forceinline__ void exp_store(const ExpItem& x, f32x4 (&a)[4][4], LAS unsigned char* scr, const int lane) {
    const int nl = (lane & 7) * 4, kq = lane >> 3;
#pragma unroll
    for (int p = 0; p < 4; ++p) { const int kk = p * 32 + kq * 4;
#pragma unroll
        for (int r = 0; r < 4; ++r) a[p][r] = a[p][r] * ((E1 ? x.gain[x.k0 + kk + r] : 1.0f) * W8SCALE);
#pragma unroll
        for (int j = 0; j < 4; ++j) *(LAS unsigned*)(scr + (nl + j) * 144 + kk) = pack4_fp8(a[p][0][j], a[p][1][j], a[p][2][j], a[p][3][j]); }
    LDS_WAIT();
#pragma unroll
    for (int q = 0; q < 4; ++q) { const int n = q * 8 + (lane >> 3), ch = lane & 7;
        const u32x4 v = *(const LAS u32x4*)(scr + n * 144 + ch * 16);
        const int ns = x.n0 + n; int dr;
        if (E1) { const int bj = ns >> 10, rr = ns & 1023; dr = x.doff + (rr >> 7) * 256 + bj * 128 + (rr & 127); } else dr = x.doff + ns;
        *(u32x4*)(x.WT + (size_t)dr * x.K + x.k0 + ch * 16) = v; }
    LDS_WAIT();
}
__device__ __forceinline__ int opaque_s(int v) { asm volatile("" : "+s"(v)); return v; }
template <bool E1>
__device__ __forceinline__ void expert_convert(const float* we1, const float* we2, const float* gffn, unsigned char* ws, LAS unsigned char* scr, const int lo, const int hi, const int gw, const int NGW, const int lane) {
    f32x4 A[4][4], B[4][4];
    int it = lo + gw;
    if (it < hi) exp_load(exp_item(opaque_s(it), we1, we2, gffn, ws), A, lane);
    for (; it < hi; it += 2 * NGW) { const int it1 = it + NGW, it2 = it1 + NGW;
        if (it1 < hi) exp_load(exp_item(opaque_s(it1), we1, we2, gffn, ws), B, lane);
        exp_store<E1>(exp_item(opaque_s(it), we1, we2, gffn, ws), A, scr, lane);
        if (it1 < hi) { if (it2 < hi) exp_load(exp_item(opaque_s(it2), we1, we2, gffn, ws), A, lane);
            exp_store<E1>(exp_item(opaque_s(it1), we1, we2, gffn, ws), B, scr, lane); } }
}
struct MapIdent { int off; __device__ __forceinline__ int operator()(int n) const { return off + n; } };
struct MapWin {
    __device__ __forceinline__ int operator()(int n) const {
        if (n < 1024) { const int blk = n >> 9, r = n & 511, tile = r >> 8, w = (r & 255) >> 6, half = (r & 63) >> 5, i = r & 31; return blk * 512 + tile * 256 + w * 64 + (i >> 3) * 16 + half * 8; }
        if (n < 1536) return 3584 + (n - 1024);
        return n - 512;
    }
};
struct MapGlu { __device__ __forceinline__ int operator()(int n) const { const int bj = n >> 9, r = n & 511; return (r >> 7) * 256 + bj * 128 + (r & 127); } };
struct MapE1 { int off; __device__ __forceinline__ int operator()(int n) const { const int bj = n >> 10, r = n & 1023; return off + (r >> 7) * 256 + bj * 128 + (r & 127); } };

struct Params {
    const float* in[34]; float* out; unsigned char* ws; int ph_lo, ph_hi;
};
enum { I_X = 0, I_MEM, I_NMIXG, I_WIN, I_LQ1, I_LK1, I_LQ2, I_LK2, I_SUBLN, I_ARE, I_AIM, I_LOGDT, I_BRE, I_BIM, I_CRE, I_CIM, I_SSMD, I_WGLU, I_WBA, I_WBS, I_WMIX, I_NCROSSG, I_NMEMG,
       I_WXQ, I_WXKV, I_WXO, I_NFFNG, I_WROUTER, I_BROUTER, I_WE1, I_BE1, I_WE2, I_BE2, I_NFING };

typedef const Params __attribute__((address_space(4)))* KParams;
__device__ __forceinline__ void prologue_phase(LAS unsigned char* lds, KParams Pk, unsigned char* ws, const int G, const int c, const int wid) {
    const int lane = fresh_lane(), tid = wid * 64 + lane;
    const int gw = c * 8 + wid, NGW = G * 8;
    LAS unsigned char* scr = lds + wid * 16384;
    constexpr int IT_WIN = 16 * 64, IT_GLU = 8 * 16, IT_BA = 8 * 16, IT_MIX = 16 * 16, IT_XQ = 256, IT_XKV = 16 * 32, IT_XO = 256, IT_E1 = 16 * 32, IT_E2 = 16 * 16;
    constexpr int NIT = IT_WIN + IT_GLU + 2 * IT_BA + IT_MIX + IT_XQ + IT_XKV + IT_XO;
    for (int it = gw; it < NIT; it += NGW) {
        int r = it;
        if (r < IT_WIN) { transpose_item<true>(Pk->in[I_WIN], 1024, 4096, (bf16_t*)(ws + WS_WIN), Pk->in[I_NMIXG], MapWin{}, scr, r, lane); continue; } r -= IT_WIN;
        if (r < IT_GLU) { transpose_item<false>(Pk->in[I_WGLU], 512, 1024, (bf16_t*)(ws + WS_WGLU), nullptr, MapGlu{}, scr, r, lane); continue; } r -= IT_GLU;
        if (r < IT_BA) { transpose_item<false>(Pk->in[I_WBA], 512, 1024, (bf16_t*)(ws + WS_WBA), nullptr, MapIdent{0}, scr, r, lane, 1024); continue; } r -= IT_BA;
        if (r < IT_BA) { transpose_item<false>(Pk->in[I_WBS], 512, 1024, (bf16_t*)(ws + WS_WBA) + 512, nullptr, MapIdent{0}, scr, r, lane, 1024); continue; } r -= IT_BA;
        if (r < IT_MIX) { transpose_item<false>(Pk->in[I_WMIX], 1024, 1024, (bf16_t*)(ws + WS_WMIX), nullptr, MapIdent{0}, scr, r, lane); continue; } r -= IT_MIX;
        if (r < IT_XQ) { transpose_item<true>(Pk->in[I_WXQ], 1024, 1024, (bf16_t*)(ws + WS_WXQ), Pk->in[I_NCROSSG], MapIdent{0}, scr, r, lane); continue; } r -= IT_XQ;
        if (r < IT_XKV) { transpose_item<false>(Pk->in[I_WXKV], 1024, 2048, (bf16_t*)(ws + WS_WXK), nullptr, MapIdent{0}, scr, r, lane); continue; } r -= IT_XKV;
        transpose_item<false>(Pk->in[I_WXO], 1024, 1024, (bf16_t*)(ws + WS_WXO), nullptr, MapIdent{0}, scr, r, lane);
    }
    { bf16_t* XB = (bf16_t*)(ws + WS_XB); float* rstd0 = (float*)(ws + WS_RSTD0); const float* x = Pk->in[I_X];
      for (int m = gw; m < NTOK; m += NGW) { f32x4 v[4]; float s = 0.f;
#pragma unroll
          for (int q = 0; q < 4; ++q) { v[q] = *(const f32x4*)(x + (size_t)m * 1024 + q * 256 + lane * 4); s += (v[q][0] * v[q][0] + v[q][1] * v[q][1]) + (v[q][2] * v[q][2] + v[q][3] * v[q][3]); }
          s = wave_sum(s);
#pragma unroll
          for (int q = 0; q < 4; ++q) *(u32x2*)(XB + (size_t)m * 1024 + q * 256 + lane * 4) = (u32x2){cvt_pk_bf16(v[q][0], v[q][1]), cvt_pk_bf16(v[q][2], v[q][3])};
          if (lane == 0) rstd0[m] = __builtin_amdgcn_rsqf(s * (1.0f / DM) + EPS); } }
    { bf16_t* MN = (bf16_t*)(ws + WS_MEMN); const float* mem = Pk->in[I_MEM]; const float* gm = Pk->in[I_NMEMG];
      for (int m = gw; m < NMEMTOK; m += NGW) { f32x4 v[4]; float s = 0.f;
#pragma unroll
          for (int q = 0; q < 4; ++q) { v[q] = *(const f32x4*)(mem + (size_t)m * 1024 + q * 256 + lane * 4); s += (v[q][0] * v[q][0] + v[q][1] * v[q][1]) + (v[q][2] * v[q][2] + v[q][3] * v[q][3]); }
          const float rs = __builtin_amdgcn_rsqf(wave_sum(s) * (1.0f / DM) + EPS);
#pragma unroll
          for (int q = 0; q < 4; ++q) { const f32x4 g = *(const f32x4*)(gm + q * 256 + lane * 4); const f32x4 o = v[q] * rs * g;
              *(u32x2*)(MN + (size_t)m * 1024 + q * 256 + lane * 4) = (u32x2){cvt_pk_bf16(o[0], o[1]), cvt_pk_bf16(o[2], o[3])}; } } }
    const int gt = c * 512 + tid, NGT = G * 512;
    { float* rope = (float*)(ws + WS_ROPE);
      for (int i = gt; i < SEQ * 32; i += NGT) { const int pos = i >> 5, f = i & 31; const float inv = exp2f(-(float)f * (13.287712379549449f / 32.0f)); float sn, cs; sincosf((float)pos * inv, &sn, &cs); rope[2 * i] = cs; rope[2 * i + 1] = sn; } }
    {
      float* AB = (float*)(ws + WS_S5AB); bf16_t* BB = (bf16_t*)(ws + WS_S5BB); bf16_t* CC = (bf16_t*)(ws + WS_S5CC);
      for (int i2 = gt; i2 < 2 * 32 * 64 * 16; i2 += NGT) { const int h = i2 & 15, i = i2 >> 4, dg = i >> 6, p = i & 63;
          const float are = Pk->in[I_ARE][i], aim = Pk->in[I_AIM][i], dt = expf(Pk->in[I_LOGDT][dg]);
          const float mag = expf(are * dt), ang = aim * dt; float sn, cs; sincosf(ang, &sn, &cs);
          const float abr = mag * cs, abi = mag * sn, den = are * are + aim * aim, nr = abr - 1.0f;
          const float cre = (nr * are + abi * aim) / den, cim = (abi * are - nr * aim) / den;
          if (h == 0) { AB[2 * i] = abr; AB[2 * i + 1] = abi; }
          const float br = Pk->in[I_BRE][(size_t)i * 16 + h], bi = Pk->in[I_BIM][(size_t)i * 16 + h];
          BB[((size_t)dg * 128 + 2 * p) * 16 + h] = (bf16_t)(cvt_pk_bf16(cre * br - cim * bi, 0.f) & 0xffffu);
          BB[((size_t)dg * 128 + 2 * p + 1) * 16 + h] = (bf16_t)(cvt_pk_bf16(cre * bi + cim * br, 0.f) & 0xffffu);
          const float crv = Pk->in[I_CRE][(size_t)dg * 16 * 64 + h * 64 + p], civ = Pk->in[I_CIM][(size_t)dg * 16 * 64 + h * 64 + p];
          CC[((size_t)dg * 16 + h) * 128 + 2 * p] = (bf16_t)(cvt_pk_bf16(crv, 0.f) & 0xffffu);
          CC[((size_t)dg * 16 + h) * 128 + 2 * p + 1] = (bf16_t)(cvt_pk_bf16(-civ, 0.f) & 0xffffu); } }
    {
      bf16_t* WR = (bf16_t*)(ws + WS_WR); const float* wrt = Pk->in[I_WROUTER]; const float* gf = Pk->in[I_NFFNG];
      for (int i = gt; i < 32 * 1024; i += NGT) { const int e = i >> 10, k = i & 1023; const float v = wrt[k * 32 + e] * gf[k]; const unsigned hb = cvt_pk_bf16(v, 0.f) & 0xffffu; const float lo = v - bf_lo(hb);
          const int pos = ((((k >> 5) * 4 + (e >> 4)) * 64 + ((k >> 3) & 3) * 16 + (e & 15)) << 3) + (k & 7);
          WR[pos] = (bf16_t)hb; WR[pos + 2 * 64 * 8] = (bf16_t)(cvt_pk_bf16(lo, 0.f) & 0xffffu); } }
    if (c == G - 1 && wid == 7) { const float s1 = wave_sum(Pk->in[I_LQ1][lane] * Pk->in[I_LK1][lane]), s2 = wave_sum(Pk->in[I_LQ2][lane] * Pk->in[I_LK2][lane]);
        if (lane == 0) *(float*)(ws + WS_LAM) = expf(s1) - expf(s2) + LAMBDA_INIT; }
}
constexpr int S5_T = 32, S5_NC = SEQ / S5_T, S5_BP = 132  , S5_BU = S5_T * S5_BP * 4, S5_XP = 272, S5_X = S5_T * S5_XP, S5_WAVE = S5_BU + S5_X;
static_assert(4 * S5_WAVE + 4 * 8192 <= PHASE_LDS, "S5 LDS");
__device__ __forceinline__ float gelu_tanh(float x) { const float z = 0.7978845608028654f * (x + 0.044715f * x * x * x); return x * __builtin_amdgcn_rcpf(1.0f + __builtin_amdgcn_exp2f(-2.0f * LOG2E * z)); }
template <int DIR>
__device__ __forceinline__ void s5_scan_wave(LAS unsigned char* lds, const bf16_t* U, float* YP, bf16_t* SG, const float* s5ab, const bf16_t* s5bb, const bf16_t* s5cc, const float* dskip, const int pair, const int wid, const int lane) {
    const int fr = lane & 15, fq = lane >> 4;
        const int dir = DIR, b = pair >> 5, g = pair & 31;
        LAS float* BU = (LAS float*)(lds + (wid & 3) * S5_WAVE); LAS unsigned char* XS = lds + (wid & 3) * S5_WAVE + S5_BU;
        bf16x8 bb[8], cc[4]; float ar, ai, nai, xr = 0.f, xi = 0.f, dsk;
        { const bf16_t* bp = s5bb + (size_t)(dir * 32 + g) * 128 * 16;
#pragma unroll
          for (int cb = 0; cb < 8; ++cb) { if (fq < 2) bb[cb] = *(const bf16x8*)(bp + (cb * 16 + fr) * 16 + fq * 8); else bb[cb] = (bf16x8){0, 0, 0, 0, 0, 0, 0, 0}; }
          const bf16_t* cp = s5cc + (size_t)(dir * 32 + g) * 16 * 128;
#pragma unroll
          for (int kb = 0; kb < 4; ++kb) cc[kb] = *(const bf16x8*)(cp + fr * 128 + kb * 32 + fq * 8);
          const float* ap = s5ab + ((size_t)(dir * 32 + g) * 64 + lane) * 2; ar = ap[0]; ai = ap[1]; nai = -ai;
          dsk = dskip[g * 16 + fr]; }
        const bf16x8 zero8 = (bf16x8){0, 0, 0, 0, 0, 0, 0, 0};
#define S5_TC(ci_) (dir ? (S5_NC - 1 - (ci_)) : (ci_))
#define S5_LOADU(ci_, A0, A1) do { const int l_ = fresh_lane(), fr = l_ & 15, fq = l_ >> 4; const size_t tk_ = (size_t)b * SEQ + S5_TC(ci_) * S5_T; const bf16_t* p0_ = U + (tk_ + fr) * 512 + g * 16 + (fq & 1) * 8; const bf16_t* p1_ = p0_ + 16 * 512; \
            asm volatile("global_load_dwordx4 %0, %1, off" : "=v"(A0) : "v"(p0_) : "memory"); asm volatile("global_load_dwordx4 %0, %1, off" : "=v"(A1) : "v"(p1_) : "memory"); } while (0)
#define S5_LOADPU(ci_) do { const int l_ = fresh_lane(), fr = l_ & 15, fq = l_ >> 4; const size_t tk_ = (size_t)b * SEQ + S5_TC(ci_) * S5_T; _Pragma("unroll") for (int q_ = 0; q_ < 8; ++q_) { const size_t off_ = (tk_ + (q_ >> 2) * 16 + fq * 4 + (q_ & 3)) * 512 + g * 16 + fr; const float* yp_ = YP + off_; const bf16_t* up_ = U + off_; \
            asm volatile("global_load_dword %0, %1, off sc1" : "=v"(pt[q_]) : "v"(yp_) : "memory"); asm volatile("global_load_ushort %0, %1, off" : "=v"(uv[q_]) : "v"(up_) : "memory"); } } while (0)
#define S5_TIE_U(A0, A1) asm volatile("" : "+v"(A0), "+v"(A1) :: "memory")
#define S5_TIE_PU() asm volatile("" : "+v"(pt[0]), "+v"(pt[1]), "+v"(pt[2]), "+v"(pt[3]), "+v"(pt[4]), "+v"(pt[5]), "+v"(pt[6]), "+v"(pt[7]), "+v"(uv[0]), "+v"(uv[1]), "+v"(uv[2]), "+v"(uv[3]), "+v"(uv[4]), "+v"(uv[5]), "+v"(uv[6]), "+v"(uv[7]) :: "memory")
#define S5_BUM(i, A0, A1) do { const bf16x8 ua_ = ((i) >> 3) ? A1 : A0; const f32x4 d_ = __builtin_amdgcn_mfma_f32_16x16x32_bf16(fq < 2 ? ua_ : zero8, bb[(i) & 7], (f32x4){0.f, 0.f, 0.f, 0.f}, 0, 0, 0); \
            _Pragma("unroll") for (int j_ = 0; j_ < 4; ++j_) BU[(((i) >> 3) * 16 + fq * 4 + j_) * S5_BP + ((i) & 7) * 16 + fr] = d_[j_]; } while (0)
#define S5_OUT(H, ci_) do { const int l_ = fresh_lane(), fr = l_ & 15, fq = l_ >> 4; const size_t tk_ = (size_t)b * SEQ + S5_TC(ci_) * S5_T; _Pragma("unroll") for (int rb_ = 0; rb_ < 2; ++rb_) { \
            if (H == 0) { float* d_ = YP + (tk_ + rb_ * 16 + fq * 4 + 2) * 512 + g * 16 + fr; \
                asm volatile("s_nop 7\n\ts_nop 7\n\ts_nop 4\n\tglobal_store_dword %0, %1, off offset:-4096\n\tglobal_store_dword %0, %2, off offset:-2048\n\tglobal_store_dword %0, %3, off\n\tglobal_store_dword %0, %4, off offset:2048" \
                             :: "v"(d_), "v"(yv[rb_][0]), "v"(yv[rb_][1]), "v"(yv[rb_][2]), "v"(yv[rb_][3]) : "memory"); } \
            else { bf16_t* d_ = SG + (tk_ + rb_ * 16 + fq * 4) * 512 + g * 16 + fr; \
                asm volatile("global_store_short %0, %1, off\n\tglobal_store_short %0, %2, off offset:1024\n\tglobal_store_short %0, %3, off offset:2048\n\tglobal_store_short %0, %4, off offset:3072" \
                             :: "v"(d_), "v"(pk[rb_ * 4 + 0]), "v"(pk[rb_ * 4 + 1]), "v"(pk[rb_ * 4 + 2]), "v"(pk[rb_ * 4 + 3]) : "memory"); } } } while (0)
#define S5_ITER(H) do { \
              \
            pa0 = qa0; pa1 = qa1; \
            if (H == 1) { _Pragma("unroll") for (int q = 0; q < 8; ++q) z[q] = pt[q] + dsk * bf_lo(uv[q]); } \
              \
            if (H == 1) S5_LOADPU(k); \
            if (k + 2 < ci1) S5_LOADU(k + 2, qa0, qa1); \
              \
            f32x2 bu[S5_T]; \
            _Pragma("unroll") for (int s = 0; s < S5_T; ++s) { const int t = DIR ? (S5_T - 1 - s) : s; bu[s] = *(const LAS f32x2*)(BU + t * S5_BP + 2 * lane); } \
            yv[0] = (f32x4){0.f, 0.f, 0.f, 0.f}; yv[1] = yv[0]; \
            { bf16x8 xa[2][4]; \
              _Pragma("unroll") for (int rb = 0; rb < 2; ++rb) _Pragma("unroll") for (int kb = 0; kb < 4; ++kb) xa[rb][kb] = *(const LAS bf16x8*)(XS + (rb * 16 + fr) * S5_XP + (kb * 32 + fq * 8) * 2); \
              LDS_WAIT(); \
              _Pragma("unroll") for (int q = 0; q < 8; ++q) yv[q >> 2] = __builtin_amdgcn_mfma_f32_16x16x32_bf16(xa[q >> 2][q & 3], cc[q & 3], yv[q >> 2], 0, 0, 0); } \
            __builtin_amdgcn_sched_barrier(0); \
              \
            unsigned pk[8]; _Pragma("unroll") for (int q = 0; q < 8; ++q) pk[q] = 0u; \
            _Pragma("unroll") for (int w = 0; w < 16; ++w) { \
                const bf16x8 ua_ = (w >> 3) ? pa1 : pa0; const f32x4 d_ = __builtin_amdgcn_mfma_f32_16x16x32_bf16(fq < 2 ? ua_ : zero8, bb[w & 7], (f32x4){0.f, 0.f, 0.f, 0.f}, 0, 0, 0); \
                _Pragma("unroll") for (int s2 = 0; s2 < 2; ++s2) { const int s = 2 * w + s2; const int t = DIR ? (S5_T - 1 - s) : s; float t1, t2; \
                    asm("v_fma_f32 %0, %1, %2, %3" : "=v"(t1) : "v"(nai), "v"(xi), "v"(bu[s].x)); \
                    asm("v_fma_f32 %0, %1, %2, %3" : "=v"(t2) : "v"(ai), "v"(xr), "v"(bu[s].y)); \
                    asm("v_fma_f32 %0, %1, %2, %3" : "=v"(xr) : "v"(ar), "v"(xr), "v"(t1)); \
                    asm("v_fma_f32 %0, %1, %2, %3" : "=v"(xi) : "v"(ar), "v"(xi), "v"(t2)); \
                    *(LAS unsigned*)(XS + t * S5_XP + lane * 4) = cvt_pk_bf16(xr, xi); } \
                if (H == 1 && (w & 1)) { const int q = w >> 1; pk[q] = cvt_pk_bf16(gelu_tanh(yv[q >> 2][q & 3] + z[q]), 0.f); } \
                _Pragma("unroll") for (int j_ = 0; j_ < 4; ++j_) BU[((w >> 3) * 16 + fq * 4 + j_) * S5_BP + (w & 7) * 16 + fr] = d_[j_]; \
                __builtin_amdgcn_sched_barrier(0); } \
              \
            if (k > ci0) S5_OUT(H, k - 1); \
              \
            if (k > ci0) asm volatile("s_waitcnt vmcnt(8)" ::: "memory"); else asm volatile("s_waitcnt vmcnt(0)" ::: "memory"); \
            S5_TIE_U(qa0, qa1); if (H == 1) S5_TIE_PU(); \
            LDS_WAIT(); } while (0)
#define S5_HALF(H) do { const int ci0 = (H) * (S5_NC / 2), ci1 = ((H) + 1) * (S5_NC / 2); \
            _Pragma("unroll") for (int q = 0; q < 8; ++q) { pt[q] = 0.f; uv[q] = 0u; z[q] = 0.f; } \
              \
            S5_LOADU(ci0, pa0, pa1); S5_LOADU(ci0 + 1, qa0, qa1); \
            asm volatile("s_waitcnt vmcnt(0)" ::: "memory"); S5_TIE_U(pa0, pa1); S5_TIE_U(qa0, qa1); \
            _Pragma("unroll") for (int i = 0; i < 16; ++i) S5_BUM(i, pa0, pa1); \
            LDS_WAIT(); \
            for (int k = ci0; k < ci1; ++k) S5_ITER(H); \
              \
            { bf16x8 xa[2][4]; unsigned pk[8]; \
              _Pragma("unroll") for (int rb = 0; rb < 2; ++rb) _Pragma("unroll") for (int kb = 0; kb < 4; ++kb) xa[rb][kb] = *(const LAS bf16x8*)(XS + (rb * 16 + fr) * S5_XP + (kb * 32 + fq * 8) * 2); \
              LDS_WAIT(); \
              yv[0] = (f32x4){0.f, 0.f, 0.f, 0.f}; yv[1] = yv[0]; \
              _Pragma("unroll") for (int q = 0; q < 8; ++q) yv[q >> 2] = __builtin_amdgcn_mfma_f32_16x16x32_bf16(xa[q >> 2][q & 3], cc[q & 3], yv[q >> 2], 0, 0, 0); \
              asm volatile("s_waitcnt vmcnt(0)" ::: "memory"); \
              _Pragma("unroll") for (int q = 0; q < 8; ++q) pk[q] = 0u; \
              if (H == 1) { S5_TIE_PU(); _Pragma("unroll") for (int q = 0; q < 8; ++q) pk[q] = cvt_pk_bf16(gelu_tanh(yv[q >> 2][q & 3] + pt[q] + dsk * bf_lo(uv[q])), 0.f); } \
              const int k = ci1; S5_OUT(H, k - 1); } \
            VM_WAIT(); \
            __syncthreads(); } while (0)
        { bf16x8 pa0, pa1, qa0 = zero8, qa1 = zero8; float pt[8], z[8]; unsigned uv[8]; f32x4 yv[2];
          S5_HALF(0);
          S5_HALF(1); }
#undef S5_ITER
#undef S5_HALF
#undef S5_TC
#undef S5_LOADU
#undef S5_LOADPU
#undef S5_TIE_U
#undef S5_TIE_PU
#undef S5_BUM
#undef S5_OUT
}
__device__ __forceinline__ void s5_phase(LAS unsigned char* lds, const bf16_t* U, float* YP, bf16_t* SG, const float* s5ab, const bf16_t* s5bb, const bf16_t* s5cc, const float* dskip, const float* we1, const float* we2, const float* gffn, unsigned char* ws, const int G, const int c, const int wid, const bool doconv = true, const bool doscan = true) {
    const int lane = fresh_lane(), tid = wid * 64 + lane, fr = lane & 15, fq = lane >> 4;
    for (int pp = c; pp < NBATCH * 32 / 2; pp += G) {
      if (wid < 4) {
        const int pair = pp * 2 + ((wid >> 1) & 1);
        if (!doscan) { __syncthreads(); __syncthreads(); }
        else if (wid & 1) s5_scan_wave<1>(lds, U, YP, SG, s5ab, s5bb, s5cc, dskip, pair, wid, lane); else s5_scan_wave<0>(lds, U, YP, SG, s5ab, s5bb, s5cc, dskip, pair, wid, lane);
      } else {
        LAS unsigned char* cscr = lds + 4 * S5_WAVE + (wid - 4) * 8192; const int gw4 = c * 4 + (wid - 4), n4 = G * 4;
        if (pp == c && doconv) expert_convert<true>(we1, we2, gffn, ws, cscr, 0, 12288, gw4, n4, lane);
        VM_WAIT(); __syncthreads();
        if (pp == c && doconv) { expert_convert<true>(we1, we2, gffn, ws, cscr, 12288, 16384, gw4, n4, lane); expert_convert<false>(we1, we2, gffn, ws, cscr, 16384, 24576, gw4, n4, lane); }
        VM_WAIT(); __syncthreads();
      }
    }
}

__device__ __forceinline__ void router_phase(LAS unsigned char* lds, const bf16_t* __restrict__ H2B, const float* ss2, const bf16_t* wr, const float* brouter, int* topi, float* gatev, int* gcnt, int* rowtok, float* roww, float* rscale, int* slotof, const int G, const int c, const int wid) {
    const int lane = fresh_lane(), tid = wid * 64 + lane, fr = lane & 15, fq = lane >> 4;
    LAS int* hist = (LAS int*)(lds + TAB_OFF) + 576;
    LAS float* lg = (LAS float*)(lds + 131072 + wid * 2112);
    static_assert(131072 + 8 * 2112 <= PHASE_LDS, "router LDS");
    if (tid < 32) hist[tid] = 0;
    { const u32x4* src = (const u32x4*)wr + tid;
#pragma unroll 1
      for (int i0 = 0; i0 < 16; i0 += 8) { u32x4 t[8];
#pragma unroll
          for (int i = 0; i < 8; ++i) t[i] = src[(i0 + i) * 512];
#pragma unroll
          for (int i = 0; i < 8; ++i) *(LAS u32x4*)(lds + ((i0 + i) * 512 + tid) * 16) = t[i]; } }
    __syncthreads();
    for (int task = c * 8 + wid; task < NTOK / 16; task += G * 8) {
        const int tok0 = task * 16;
        f32x4 a0 = (f32x4){0.f, 0.f, 0.f, 0.f}, a1 = a0;
        const bf16_t* ap = H2B + (size_t)(tok0 + fr) * 1024 + fq * 8;
        const LAS unsigned char* bp = lds + lane * 16;
#pragma unroll 1
        for (int k0 = 0; k0 < 32; k0 += 16) { bf16x8 av[16];
#pragma unroll
            for (int i = 0; i < 16; ++i) av[i] = *(const bf16x8*)(ap + (k0 + i) * 32);
#pragma unroll
            for (int i = 0; i < 16; ++i) { const LAS unsigned char* q = bp + (k0 + i) * 4096;
                a0 = __builtin_amdgcn_mfma_f32_16x16x32_bf16(av[i], *(const LAS bf16x8*)(q), a0, 0, 0, 0); a0 = __builtin_amdgcn_mfma_f32_16x16x32_bf16(av[i], *(const LAS bf16x8*)(q + 2048), a0, 0, 0, 0);
                a1 = __builtin_amdgcn_mfma_f32_16x16x32_bf16(av[i], *(const LAS bf16x8*)(q + 1024), a1, 0, 0, 0); a1 = __builtin_amdgcn_mfma_f32_16x16x32_bf16(av[i], *(const LAS bf16x8*)(q + 3072), a1, 0, 0, 0); } }
        const float br0 = brouter[fr], br1 = brouter[16 + fr];
#pragma unroll
        for (int j = 0; j < 4; ++j) { const int t = fq * 4 + j; const float rs = row_rstd16(ss2, tok0 + t); lg[t * 33 + fr] = a0[j] * rs + br0; lg[t * 33 + 16 + fr] = a1[j] * rs + br1; }
        LDS_WAIT();
        if (lane < 16) {
            float v0 = -3e38f, v1 = -3e38f, v2 = -3e38f, v3 = -3e38f; int i0 = 0, i1 = 0, i2 = 0, i3 = 0;
#pragma unroll
            for (int e = 0; e < 32; ++e) { const float v = lg[lane * 33 + e];
                if (v > v0) { v3 = v2; i3 = i2; v2 = v1; i2 = i1; v1 = v0; i1 = i0; v0 = v; i0 = e; }
                else if (v > v1) { v3 = v2; i3 = i2; v2 = v1; i2 = i1; v1 = v; i1 = e; }
                else if (v > v2) { v3 = v2; i3 = i2; v2 = v; i2 = e; }
                else if (v > v3) { v3 = v; i3 = e; } }
            const float e1 = __expf(v1 - v0), e2 = __expf(v2 - v0), e3 = __expf(v3 - v0), inv = 1.0f / (1.0f + e1 + e2 + e3);
            const int tok = tok0 + lane;
            *(int4*)(topi + (size_t)tok * 4) = make_int4(i0, i1, i2, i3);
            *(f32x4*)(gatev + (size_t)tok * 4) = (f32x4){inv, e1 * inv, e2 * inv, e3 * inv};
            atomicAdd((int*)&hist[i0], 1); atomicAdd((int*)&hist[i1], 1); atomicAdd((int*)&hist[i2], 1); atomicAdd((int*)&hist[i3], 1);
        }
        LDS_WAIT();
    }
    __syncthreads();
    LAS int* run = (LAS int*)(lds + TAB_OFF) + 608; LAS int* base = (LAS int*)(lds + TAB_OFF) + 640;
    if (tid < 32) { base[tid] = atomicAdd(&gcnt[tid], hist[tid]); run[tid] = 0; }
    __syncthreads();
    for (int task = c * 8 + wid; task < NTOK / 16; task += G * 8) {
        if (lane < 16) { const int tok = task * 16 + lane; const int4 ti = *(const int4*)(topi + (size_t)tok * 4); const f32x4 gv = *(const f32x4*)(gatev + (size_t)tok * 4);
            const float rs = row_rstd16(ss2, tok); const int ee[4] = {ti.x, ti.y, ti.z, ti.w}; int sl[4];
#pragma unroll
            for (int k = 0; k < 4; ++k) { const int r = base[ee[k]] + atomicAdd((int*)&run[ee[k]], 1); const size_t ix = (size_t)ee[k] * MOE_CAP + r; sl[k] = (ee[k] << 16) | r; rowtok[ix] = tok; roww[ix] = gv[k]; rscale[ix] = rs; }
            *(int4*)(slotof + (size_t)tok * 4) = make_int4(sl[0], sl[1], sl[2], sl[3]); }
    }
}

__device__ __forceinline__ void moe_tables(LAS unsigned char* lds, const int* gcnt, const int G, const int c, const int wid) {
    LAS int* T = (LAS int*)(lds + TAB_OFF); LAS int* blk_e = T; LAS int* tot = T + 672; LAS int* nblkp = T + 704; LAS int* fb = T + 720;
    const int tid = wid * 64 + fresh_lane();
    if (wid == 0) {
        const int l = tid; const int n = (l < 32) ? gcnt[l & 31] : 0; const int nbe = (n + 255) >> 8; int inc = nbe;
#pragma unroll
        for (int o = 1; o < 32; o <<= 1) { const int v = __shfl_up(inc, o); if (l >= o) inc += v; }
        const int pre = inc - nbe;
        if (l < 32) { tot[l] = n; fb[l] = pre; for (int k = 0; k < nbe; ++k) blk_e[pre + k] = l; }
        if (l == 31) nblkp[0] = inc; }
    __syncthreads();
}
__device__ __forceinline__ void moe_pad_rows(LAS unsigned char* lds, int* rowtok, float* roww, float* rscale, const int wid) {
    const LAS int* tot = (const LAS int*)(lds + TAB_OFF) + 672; const int tid = wid * 64 + fresh_lane();
    for (int e = 0; e < 32; ++e) { const int n = tot[e], pe = ((n + 255) >> 8) << 8;
        for (int r = n + tid; r < pe; r += 512) { const size_t ix = (size_t)e * MOE_CAP + r; rowtok[ix] = 0; roww[ix] = 0.f; rscale[ix] = 0.f; } }
    VM_WAIT(); __syncthreads();
}
__device__ __forceinline__ void combine_phase(LAS unsigned char* lds, const bf16_t* __restrict__ H2B, const unsigned char* __restrict__ YS, const int* slotof, const int* gcnt, const float* gfin, float* out, const int G, const int c, const int wid) {
    const int lane = fresh_lane(), tid = wid * 64 + lane;
    moe_tables(lds, gcnt, G, c, wid); const LAS int* fb = (const LAS int*)(lds + TAB_OFF) + 720;
    f32x4 g[4];
#pragma unroll
    for (int q = 0; q < 4; ++q) g[q] = *(const f32x4*)(gfin + q * 256 + lane * 4);
    for (int tok = c * 8 + wid; tok < NTOK; tok += G * 8) {
        const int4 sl = *(const int4*)(slotof + (size_t)tok * 4); const int ss[4] = {fb[sl.x >> 16] * 256 + (sl.x & 0xffff), fb[sl.y >> 16] * 256 + (sl.y & 0xffff), fb[sl.z >> 16] * 256 + (sl.z & 0xffff), fb[sl.w >> 16] * 256 + (sl.w & 0xffff)};
        f32x4 v[4]; float sq = 0.f;
#pragma unroll
        for (int q = 0; q < 4; ++q) { const u32x2 hw = *(const u32x2*)(H2B + (size_t)tok * 1024 + q * 256 + lane * 4); v[q] = (f32x4){bf_lo(hw.x), bf_hi(hw.x), bf_lo(hw.y), bf_hi(hw.y)}; }
#pragma unroll
        for (int k = 0; k < 4; ++k)
#pragma unroll
            for (int q = 0; q < 4; ++q) { const unsigned yw = *(const unsigned*)(YS + (size_t)ss[k] * 1024 + q * 256 + lane * 4);
                const f32x2 y01 = __builtin_amdgcn_cvt_pk_f32_fp8((int)yw, false), y23 = __builtin_amdgcn_cvt_pk_f32_fp8((int)yw, true); v[q] += (f32x4){y01.x, y01.y, y23.x, y23.y}; }
#pragma unroll
        for (int q = 0; q < 4; ++q) sq += (v[q][0] * v[q][0] + v[q][1] * v[q][1]) + (v[q][2] * v[q][2] + v[q][3] * v[q][3]);
        const float rs = __builtin_amdgcn_rsqf(wave_sum(sq) * (1.0f / DM) + EPS);
#pragma unroll
        for (int q = 0; q < 4; ++q) *(f32x4*)(out + (size_t)tok * 1024 + q * 256 + lane * 4) = v[q] * rs * g[q];
    }
}
constexpr int NPHASE = 14;
#ifndef S5P_CONV
#define S5P_CONV(r) true
#define S5P_SCAN(r) true
#endif
__global__ void __launch_bounds__(512, 2) fwd_kernel(Params P) {
    extern __shared__ __attribute__((aligned(16))) unsigned char lds_raw[];
    LAS unsigned char* lds = (LAS unsigned char*)lds_raw;
    const int G = gridDim.x, c = blockIdx.x, wid = __builtin_amdgcn_readfirstlane(threadIdx.x >> 6);
    unsigned char* ws = P.ws;
    volatile LAS unsigned* MISC = (volatile LAS unsigned*)(lds + MISC_OFF);
    if (threadIdx.x < 64) MISC[threadIdx.x] = 0u;
    __syncthreads();
    const int lo = P.ph_lo, hi = P.ph_hi;
    const bool multi = (hi - lo) > 1;
    XcdBarrier bar; bar.bar = (unsigned*)(ws + WS_CTL); bar.x = 0; bar.st = nullptr;
    if (multi) bar = xcd_barrier_post((unsigned*)(ws + WS_CTL), MISC + 8);
#ifndef ONLY_PHASE
#define ONLY_PHASE -1
#endif
#define IN(k) ((ONLY_PHASE < 0 || ONLY_PHASE == (k)) && lo <= (k) && (k) < hi)
#ifndef REP_MASK
#define REP_MASK 0
#endif
#define REPS(k) (((REP_MASK >> (k)) & 1) ? 2 : 1)
#define SEAM(k) do { if (IN(k) && IN((k) + 1)) xcd_barrier(bar, wid); } while (0)
#define SEAM2(k) do { if (IN(k) && IN((k) + 2)) xcd_barrier(bar, wid); } while (0)
    KParams kp0 = (KParams)__builtin_amdgcn_kernarg_segment_ptr(); unsigned char* const ws0 = ws;
#define ENV() KParams pk = kp0; unsigned char* w = ws0; asm volatile("" : "+s"(pk), "+s"(w))
#define BF(off) ((bf16_t*)(w + (off)))
#define F32(off) ((float*)(w + (off)))
#define I32(off) ((int*)(w + (off)))
    constexpr size_t TS1024 = 256 * 1024 * 2, TS512 = 256 * 512 * 2;

    for (int rep_ = 0; rep_ < REPS(0); ++rep_) if (IN(0)) { ENV(); prologue_phase(lds, pk, w, G, c, wid); }
    SEAM(0);
    for (int rep_ = 0; rep_ < REPS(1); ++rep_) if (IN(1)) { ENV();
        P1Sched S{(const char*)(w + WS_XB), (const char*)(w + WS_WIN), (const char*)(w + WS_MEMN), (const char*)(w + WS_WXK), (const char*)(w + WS_WXV), G, c};
        EpiP1 E{w, F32(WS_RSTD0), (const float*)(w + WS_ROPE)};
        pg8::gemm_phase<EpiP1, P1Sched, false, false, false, true>(lds, wid, 1024, 1024, 1024, S, E);
    }
    SEAM(1);
    for (int rep_ = 0; rep_ < REPS(2); ++rep_) if (IN(2)) {
        { ENV(); diff_attn_phase<0>(lds, BF(WS_Q), BF(WS_K), BF(WS_VT), BF(WS_OAS), pk->in[I_SUBLN], *(const float*)(w + WS_LAM), G, c, wid); }
#ifdef ATTN_VAR
        { ENV(); diff_attn_phase<ATTN_VAR>(lds, BF(WS_Q), BF(WS_K), BF(WS_VT), (bf16_t*)(w + 900 * MiB), pk->in[I_SUBLN], *(const float*)(w + WS_LAM), G, c, wid); }
#endif
        for (int r2_ = 0; r2_ < REPS(15); ++r2_) { ENV(); s5_phase(lds, BF(WS_U), F32(WS_YP), BF(WS_SG), (const float*)(w + WS_S5AB), (const bf16_t*)(w + WS_S5BB), (const bf16_t*)(w + WS_S5CC), pk->in[I_SSMD], pk->in[I_WE1], pk->in[I_WE2], pk->in[I_NFFNG], w, G, c, wid, S5P_CONV(r2_), S5P_SCAN(r2_)); }
    }
    SEAM(2);
    for (int rep_ = 0; rep_ < REPS(3); ++rep_) if (IN(3)) {
        { ENV(); CrossSched S{(const char*)(w + WS_MEMN), (const char*)(w + WS_WXK), (const char*)(w + WS_WXV), G, c}; EpiP1 E{w, F32(WS_RSTD0), (const float*)(w + WS_ROPE)};
          pg8::gemm_phase<EpiP1, CrossSched, false, false, false, true>(lds, wid, 1024, 1024, 1024, S, E); }
        __syncthreads();
        ENV();
        GluSched S{SimpleSched{(const char*)(w + WS_SG), (const char*)(w + WS_WGLU), TS512, TS512, 128, 4, G, c}};
        EpiGlu E{BF(WS_OAS)};
        pg8::gemm_phase<EpiGlu, GluSched, false>(lds, wid, 512, 512, 512, S, E);
#ifdef GLU_PROBE
        __syncthreads();
        { EpiProbe<GLU_PROBE> E2{(bf16_t*)(w + 900 * MiB)}; pg8::gemm_phase<EpiProbe<GLU_PROBE>, GluSched, false>(lds, wid, 512, 512, 512, S, E2); }
#endif
    }
    SEAM(3);
    for (int rep_ = 0; rep_ < REPS(4); ++rep_) if (IN(4)) { ENV();
        SimpleSched S{(const char*)(w + WS_OAS), (const char*)(w + WS_WBA), TS1024, TS1024, 128, 4, G, c}; EpiGateOut E{BF(WS_GS), BF(WS_MG)}; MidGate MHK{BF(WS_GA), BF(WS_GS)};
        #ifdef NOMID_TEST
        pg8::gemm_phase<EpiGateOut, SimpleSched, false, false, false, true>(lds, wid, 1024, 1024, 1024, S, E);
#else
        pg8::gemm_phase<EpiGateOut, SimpleSched, false, false, false, true, MidGate>(lds, wid, 1024, 1024, 1024, S, E, MHK);
#endif
    }
    SEAM(4);
    for (int rep_ = 0; rep_ < REPS(5); ++rep_) if (IN(5)) { ENV();
        SimpleSched S{(const char*)(w + WS_MG), (const char*)(w + WS_WMIX), TS1024, TS1024, 128, 4, G, c}; EpiResid<false, false> E{(const void*)(w + WS_XB), BF(WS_H1B), F32(WS_SS1), nullptr};
        pg8::gemm_phase<EpiResid<false, false>, SimpleSched, false, false, false, true>(lds, wid, 1024, 1024, 1024, S, E);
    }
    SEAM(5);
    for (int rep_ = 0; rep_ < REPS(6); ++rep_) if (IN(6)) {
#pragma unroll 1
        for (int i = 0; ; ++i) { ENV();
            SimpleSched S{(const char*)(w + WS_H1B), (const char*)(w + WS_WXQ), TS1024, TS1024, 128, 4, G, c}; GUnit uu;
            if (!S.next(i, uu)) break;
            OneUnitSched S1{S, i}; EpiXq E{BF(WS_XQ), F32(WS_SS1)};
            pg8::gemm_phase<EpiXq, OneUnitSched, false, false, false, true>(lds, wid, 1024, 1024, 1024, S1, E);
            cross_attn_unit(lds, BF(WS_XQ), BF(WS_XK), BF(WS_XVT), BF(WS_XO), uu.pm >> 3, uu.pn, uu.pm & 7, wid);
        }
    }
    SEAM(7);
    for (int rep_ = 0; rep_ < REPS(8); ++rep_) if (IN(8)) { ENV();
        SimpleSched S{(const char*)(w + WS_XO), (const char*)(w + WS_WXO), TS1024, TS1024, 128, 4, G, c}; EpiResid<false> E{(const void*)(w + WS_H1B), BF(WS_H2B), F32(WS_SS2), w + WS_H2F8};
        pg8::gemm_phase<EpiResid<false>, SimpleSched, false, false, false, true>(lds, wid, 1024, 1024, 1024, S, E);
    }
    SEAM(8);
    for (int rep_ = 0; rep_ < REPS(9); ++rep_) if (IN(9)) { ENV(); router_phase(lds, BF(WS_H2B), F32(WS_SS2), (const bf16_t*)(w + WS_WR), pk->in[I_BROUTER], I32(WS_TOPI), F32(WS_GATE), I32(WS_GCNT), I32(WS_ROWTOK), F32(WS_ROWW), F32(WS_RSCALE), I32(WS_SLOT), G, c, wid); }
    SEAM2(9);
    for (int rep_ = 0; rep_ < REPS(11); ++rep_) if (IN(11)) { ENV();
        moe_tables(lds, I32(WS_GCNT), G, c, wid);
        moe_pad_rows(lds, I32(WS_ROWTOK), F32(WS_ROWW), F32(WS_RSCALE), wid);
        const LAS int* T = (const LAS int*)(lds + TAB_OFF);
        MoeSched S{(const char*)(w + WS_H2F8), (const char*)(w + WS_WE1), I32(WS_ROWTOK), T, __builtin_amdgcn_readfirstlane(T[704]), 8, G, c, (size_t)2048 * 1024, true};
        EpiE1 E{w + WS_ACT, F32(WS_RSCALE), pk->in[I_BE1]};
        pg8::gemm_phase<EpiE1, MoeSched, true, true>(lds, wid, 512, 512, 512, S, E);
    }
    SEAM(11);
    for (int rep_ = 0; rep_ < REPS(12); ++rep_) if (IN(12)) { ENV();
        moe_tables(lds, I32(WS_GCNT), G, c, wid);
        const LAS int* T = (const LAS int*)(lds + TAB_OFF);
        MoeSched S{(const char*)(w + WS_ACT), (const char*)(w + WS_WE2), I32(WS_ROWTOK), T, __builtin_amdgcn_readfirstlane(T[704]), 4, G, c, (size_t)1024 * 1024, false};
        EpiE2 E{w + WS_YS, F32(WS_ROWW), pk->in[I_BE2]};
        pg8::gemm_phase<EpiE2, MoeSched, false, true, true, true>(lds, wid, 512, 512, 512, S, E);
#ifdef E2_PROBE
        __syncthreads();
        { EpiProbe<0> E2{(bf16_t*)(w + 900 * MiB)}; pg8::gemm_phase<EpiProbe<0>, MoeSched, false, true, true, true>(lds, wid, 512, 512, 512, S, E2); }
#endif
    }
    SEAM(12);
    for (int rep_ = 0; rep_ < REPS(13); ++rep_) if (IN(13)) { ENV(); combine_phase(lds, BF(WS_H2B), w + WS_YS, I32(WS_SLOT), I32(WS_GCNT), pk->in[I_NFING], pk->out, G, c, wid); }
#undef ENV
#undef BF
#undef F32
#undef I32
#undef IN
#undef SEAM
}

#ifndef N_LAUNCHES
#define N_LAUNCHES 1
#endif
extern "C" void kernel_launch(void* const* d_in, const int* in_sizes, int n_in, void* d_out, int out_size, void* d_ws, size_t ws_size, hipStream_t stream) {
    static int grid = 0;
    if (grid == 0) {
        if (n_in != 34 || out_size != NTOK * DM || ws_size < WS_END) { fprintf(stderr, "kernel_launch: unexpected shapes (n_in %d out %d ws %zu)\n", n_in, out_size, ws_size); grid = -1; return; }
        int dev = 0, cus = 0, per_cu = 0;
        if (hipGetDevice(&dev) != hipSuccess || hipDeviceGetAttribute(&cus, hipDeviceAttributeMultiprocessorCount, dev) != hipSuccess) { grid = -1; return; }
        if (hipFuncSetAttribute((const void*)fwd_kernel, hipFuncAttributeMaxDynamicSharedMemorySize, LDS_BYTES) != hipSuccess) { fprintf(stderr, "kernel_launch: hipFuncSetAttribute failed\n"); grid = -1; return; }
        if (hipOccupancyMaxActiveBlocksPerMultiprocessor(&per_cu, (const void*)fwd_kernel, 512, LDS_BYTES) != hipSuccess || per_cu < 1) { fprintf(stderr, "kernel_launch: occupancy query says %d\n", per_cu); }
        (void)hipGetLastError();
        grid = cus;
    }
    if (grid < 0) return;
    (void)hipMemsetAsync((char*)d_ws + WS_CTL, 0, CTL_ZERO_BYTES, stream);
    Params p{};
    for (int i = 0; i < 34; ++i) p.in[i] = (const float*)d_in[i];
    p.out = (float*)d_out; p.ws = (unsigned char*)d_ws;
#if N_LAUNCHES == 1
    p.ph_lo = 0; p.ph_hi = NPHASE;
    hipLaunchKernelGGL(fwd_kernel, dim3(grid), dim3(512), LDS_BYTES, stream, p);
#else
    for (int k = 0; k < NPHASE; ++k) { p.ph_lo = k; p.ph_hi = k + 1; hipLaunchKernelGGL(fwd_kernel, dim3(grid), dim3(512), LDS_BYTES, stream, p); }
#endif
}
```

```cpp
#include <hip/hip_runtime.h>
#include <cstdio>
#include <cstdint>

#define LAS __attribute__((address_space(3)))
#define GAS __attribute__((address_space(1)))
typedef unsigned short bf16_t;
typedef short bf16x8 __attribute__((ext_vector_type(8)));
typedef float f32x4 __attribute__((ext_vector_type(4)));
typedef float f32x2 __attribute__((ext_vector_type(2)));
typedef float f32x16 __attribute__((ext_vector_type(16)));
typedef unsigned u32x4 __attribute__((ext_vector_type(4)));
typedef unsigned u32x2 __attribute__((ext_vector_type(2)));

constexpr int NBATCH = 16, SEQ = 2048, DM = 1024, NTOK = NBATCH * SEQ;
constexpr int NMEM = 256, NMEMTOK = NBATCH * NMEM;
constexpr int NEXP = 32, TOPK = 4, NPAD = NTOK * TOPK + NEXP * 256, MAXBLK = NPAD / 256;
constexpr float EPS = 1e-6f;
constexpr float LOG2E = 1.4426950408889634f;
constexpr float QSCALE = 0.125f * LOG2E;
constexpr float XQSCALE = 0.0625f * LOG2E;
constexpr float LAMBDA_INIT = 0.2f;

constexpr size_t MiB = 1u << 20;
constexpr size_t WS_CTL = 0, CTL_ZERO_BYTES = 64 * 1024;
constexpr size_t WS_RSTD0 = 1 * MiB;
constexpr size_t WS_SS1 = 2 * MiB, WS_SS2 = 4 * MiB;
constexpr size_t WS_ROPE = 6 * MiB;
constexpr size_t WS_S5AB = 7 * MiB;
constexpr size_t WS_S5BB = WS_S5AB + 64 * 1024;
constexpr size_t WS_S5CC = WS_S5BB + 256 * 1024;
constexpr size_t WS_LAM = WS_S5CC + 256 * 1024;
constexpr size_t WS_WR = 8 * MiB;
constexpr size_t WS_TOPI = 9 * MiB, WS_GATE = WS_TOPI + 512 * 1024;
constexpr size_t WS_SLOT = 10 * MiB;
constexpr size_t WS_CNTWG = WS_SLOT + 512 * 1024;
constexpr int MOE_CAP = 32768 + 256;
constexpr size_t WS_ROWTOK = 256 * MiB, WS_ROWW = 262 * MiB, WS_RSCALE = 268 * MiB;
constexpr size_t WS_GCNT = WS_CTL + 16384;
constexpr size_t WS_WIN = 17 * MiB;
constexpr size_t WS_WGLU = 25 * MiB, WS_WBA = 26 * MiB, WS_WBS = 27 * MiB, WS_WMIX = 28 * MiB, WS_WXQ = 30 * MiB, WS_WXK = 32 * MiB, WS_WXV = 34 * MiB, WS_WXO = 36 * MiB;
constexpr size_t WS_WE1 = 38 * MiB, WS_WE2 = 166 * MiB;
constexpr size_t WS_MEMN = 232 * MiB, WS_XK = 240 * MiB, WS_XVT = 248 * MiB;
constexpr size_t WS_XB = 256 * MiB, WS_M1 = 672 * MiB;
constexpr size_t WS_Q = 320 * MiB, WS_K = 352 * MiB, WS_MG = WS_Q;
constexpr size_t WS_VT = 384 * MiB, WS_U = 416 * MiB;
constexpr size_t WS_GA = 448 * MiB, WS_XQ = WS_GA;
constexpr size_t WS_GS = 512 * MiB, WS_XO = WS_GS;
constexpr size_t WS_OAS = 576 * MiB, WS_SG = 640 * MiB, WS_YP = 672 * MiB, WS_H1B = 736 * MiB, WS_H2B = 800 * MiB;
constexpr size_t WS_XS8 = 256 * MiB;
constexpr size_t WS_ACT = 392 * MiB, WS_YS = 528 * MiB;
constexpr size_t WS_H2F8 = 864 * MiB;
constexpr size_t WS_XB8 = 896 * MiB, WS_WIN8 = 928 * MiB;
constexpr size_t WS_H1F8 = 931 * MiB, WS_WXQ8 = 963 * MiB;
constexpr size_t WS_END = 964 * MiB;
constexpr float SGSCALE = 4.0f;
constexpr float XOSCALE = 16.0f;
constexpr float W8SCALE = 64.0f, W8INV = 1.0f / 64.0f;
static_assert(WS_XS8 + (size_t)NPAD * 1024 <= WS_ACT && WS_ACT + (size_t)NPAD * 1024 <= WS_YS && WS_YS + (size_t)NPAD * 2048 <= WS_H2B, "overlay map");

constexpr int RING_BYTES = 131072;
constexpr int LDS_BYTES = 163840;
constexpr int PHASE_LDS = LDS_BYTES - 4096;
constexpr int MISC_OFF = PHASE_LDS;
constexpr int TAB_OFF = PHASE_LDS + 256;

__device__ __forceinline__ unsigned cvt_pk_bf16(float lo, float hi) { unsigned r; asm("v_cvt_pk_bf16_f32 %0, %1, %2" : "=v"(r) : "v"(lo), "v"(hi)); return r; }
__device__ __forceinline__ unsigned fp8_1(float x) { return (unsigned)__builtin_amdgcn_cvt_pk_fp8_f32(__builtin_amdgcn_fmed3f(x, -448.0f, 448.0f), 0.f, 0, false); }
__device__ __forceinline__ unsigned pack4_fp8(float a, float b, float c, float d) { int w = 0; w = __builtin_amdgcn_cvt_pk_fp8_f32(a, b, w, false); w = __builtin_amdgcn_cvt_pk_fp8_f32(c, d, w, true); return (unsigned)w; }
__device__ __forceinline__ float bf_lo(unsigned u) { return __uint_as_float(u << 16); }
__device__ __forceinline__ float bf_hi(unsigned u) { return __uint_as_float(u & 0xffff0000u); }
__device__ __forceinline__ float fast_sigmoid(float x) { return __builtin_amdgcn_rcpf(1.0f + __builtin_amdgcn_exp2f(-x * LOG2E)); }
__device__ __forceinline__ float wave_sum(float v) {
#pragma unroll
    for (int o = 1; o < 64; o <<= 1) v += __shfl_xor(v, o);
    return v;
}
__device__ __forceinline__ int fresh_lane() { int l; asm volatile("v_mbcnt_lo_u32_b32 %0, -1, 0\n\tv_mbcnt_hi_u32_b32 %0, -1, %0" : "=v"(l)); return l; }
#define LDS_WAIT() asm volatile("s_waitcnt lgkmcnt(0)" ::: "memory")
#define VM_WAIT() asm volatile("s_waitcnt vmcnt(0)" ::: "memory")

#define XB_TMO      128
#define XB_XCNT(j)  (256  + 64 * (j))
#define XB_XSUB(j)  (1280 + 64 * (j))
#define XB_XGEN(j)  (2304 + 64 * (j))
#define XB_TOP      3328
#define XB_TOPGEN   3392
#define XCD_BAR_WORDS 3456
#define XB_SPIN_CAP (1u << 18)
__device__ __forceinline__ unsigned xb_ld(unsigned* p)              { return __hip_atomic_load(p, __ATOMIC_RELAXED, __HIP_MEMORY_SCOPE_AGENT); }
__device__ __forceinline__ unsigned xb_add(unsigned* p, unsigned v) { return __hip_atomic_fetch_add(p, v, __ATOMIC_RELAXED, __HIP_MEMORY_SCOPE_AGENT); }
__device__ __forceinline__ unsigned xb_xcc_id() { return (unsigned)__builtin_amdgcn_s_getreg((3 << 11) | 20) & 0xFu; }
#define XB_SPIN(cond, bar) do { unsigned _sp = 0; while (cond) { __builtin_amdgcn_s_sleep(1); \
    if ((++_sp & 255u) == 0u) { if (xb_ld(&(bar)[XB_TMO])) break; if (_sp > XB_SPIN_CAP) { atomicAdd(&(bar)[XB_TMO], 1u); break; } } } } while (0)
struct XcdBarrier { unsigned* bar; unsigned x; volatile LAS unsigned* st; };
__device__ __forceinline__ XcdBarrier xcd_barrier_post(unsigned* bar, volatile LAS unsigned* st) {
    XcdBarrier b; b.bar = bar; b.x = xb_xcc_id(); b.st = st;
    if (threadIdx.x == 0) (void)xb_add(&bar[XB_XCNT(b.x)], 1u);
    return b;
}
__device__ __forceinline__ void xcd_barrier_complete(unsigned* bar, unsigned x, unsigned& nloc, unsigned& nx) {
    const unsigned G = gridDim.x * gridDim.y * gridDim.z;
    unsigned sum, cnt, mine, sp = 0u;
    for (;;) {
        sum = 0u; cnt = 0u; mine = 0u;
#pragma unroll
        for (unsigned j = 0; j < 16; ++j) { const unsigned c = xb_ld(&bar[XB_XCNT(j)]); sum += c; cnt += (c > 0u) ? 1u : 0u; mine = (j == x) ? c : mine; }
        if (sum == G) break;
        __builtin_amdgcn_s_sleep(1);
        if ((++sp & 255u) == 0u) { if (xb_ld(&bar[XB_TMO])) break; if (sp > XB_SPIN_CAP) { atomicAdd(&bar[XB_TMO], 1u); break; } }
    }
    nloc = mine > 0u ? mine : 1u; nx = cnt > 0u ? cnt : 1u;
}
__device__ __forceinline__ void xcd_barrier(const XcdBarrier& b, const int wid) {
    asm volatile("s_waitcnt vmcnt(0)" ::: "memory");
    __syncthreads();
    if (wid == 0 && fresh_lane() == 0) {
        unsigned* bar = b.bar;
        __builtin_amdgcn_s_waitcnt(0);
        unsigned nloc = b.st[0], nx = b.st[1];
        if (nloc == 0u) { xcd_barrier_complete(bar, b.x, nloc, nx); b.st[0] = nloc; b.st[1] = nx; }
        const unsigned old = xb_add(&bar[XB_XSUB(b.x)], 1u);
        const unsigned gen = old / nloc;
#ifndef XB_FLATREL
#define XB_FLATREL 0
#endif
#if XB_FLATREL
        if (old + 1u == (gen + 1u) * nloc) {
            __builtin_amdgcn_fence(__ATOMIC_RELEASE, "agent");
            asm volatile("s_waitcnt vmcnt(0)" ::: "memory");
            const unsigned og = xb_add(&bar[XB_TOP], 1u);
            const unsigned tg = og / nx;
            if (og + 1u == (tg + 1u) * nx) {
#pragma unroll
                for (unsigned j = 0; j < 16; ++j) (void)xb_add(&bar[XB_XGEN(j)], 1u);
            }
        }
        XB_SPIN(xb_ld(&bar[XB_XGEN(b.x)]) == gen, bar);
        __builtin_amdgcn_fence(__ATOMIC_ACQUIRE, "agent");
        asm volatile("s_waitcnt vmcnt(0)" ::: "memory");
#else
        if (old + 1u == (gen + 1u) * nloc) {
            __builtin_amdgcn_fence(__ATOMIC_RELEASE, "agent");
            asm volatile("s_waitcnt vmcnt(0)" ::: "memory");
            const unsigned og = xb_add(&bar[XB_TOP], 1u);
            const unsigned tg = og / nx;
            if (og + 1u == (tg + 1u) * nx) xb_add(&bar[XB_TOPGEN], 1u);
            else XB_SPIN(xb_ld(&bar[XB_TOPGEN]) == tg, bar);
            __builtin_amdgcn_fence(__ATOMIC_ACQUIRE, "agent");
            xb_add(&bar[XB_XGEN(b.x)], 1u);
            asm volatile("s_waitcnt vmcnt(0)" ::: "memory");
        } else {
            XB_SPIN(xb_ld(&bar[XB_XGEN(b.x)]) == gen, bar);
            __builtin_amdgcn_fence(__ATOMIC_ACQUIRE, "agent");
            asm volatile("s_waitcnt vmcnt(0)" ::: "memory");
        }
#endif
    }
    __syncthreads();
}

namespace pg8 {
constexpr int BM = 256, BK = 64, HALF = 128, HTB = HALF * BK * 2, NXCD = 8, WGM = 8;
__device__ __forceinline__ int lds_byte(int r, int c) { const int st = (r >> 4) * 2 + (c >> 5), rr = r & 15, cc = c & 31, ob = rr * 64 + cc * 2; return st * 1024 + (ob ^ (((ob >> 9) & 1) << 5)); }
__device__ __forceinline__ void stage_rc(int b, int& R, int& C) { const int st = b / 1024, sb = b % 1024, swz = sb ^ (((sb >> 9) & 1) << 5); R = (st >> 1) * 16 + swz / 64; C = (st & 1) * 32 + (swz % 64) / 2; }
__device__ __forceinline__ int perm32(int rho) { const int n = rho >> 4, i = rho & 15; return 8 * (i >> 2) + 4 * n + (i & 3); }

struct GUnit { const char* A; const char* B; const int* idx; int pm, pn, kind, e; };

typedef int v4i_t __attribute__((ext_vector_type(4))); typedef int v8i_t __attribute__((ext_vector_type(8)));
__device__ __forceinline__ v8i_t cat8(const bf16x8 a, const bf16x8 b) { const v4i_t x = __builtin_bit_cast(v4i_t, a), y = __builtin_bit_cast(v4i_t, b); return __builtin_shufflevector(x, y, 0, 1, 2, 3, 4, 5, 6, 7); }
__device__ __forceinline__ bf16x8 lo8(const v8i_t x) { return __builtin_bit_cast(bf16x8, (v4i_t)__builtin_shufflevector(x, x, 0, 1, 2, 3)); }
__device__ __forceinline__ bf16x8 hi8(const v8i_t x) { return __builtin_bit_cast(bf16x8, (v4i_t)__builtin_shufflevector(x, x, 4, 5, 6, 7)); }
template <int Q> __device__ __forceinline__ f32x16 ins4(const f32x16 X, const f32x4 c) {
    const f32x16 w = __builtin_shufflevector(c, c, 0, 1, 2, 3, 0, 1, 2, 3, 0, 1, 2, 3, 0, 1, 2, 3);
    if constexpr (Q == 0) return __builtin_shufflevector(X, w, 16, 17, 18, 19, 4, 5, 6, 7, 8, 9, 10, 11, 12, 13, 14, 15);
    else if constexpr (Q == 1) return __builtin_shufflevector(X, w, 0, 1, 2, 3, 16, 17, 18, 19, 8, 9, 10, 11, 12, 13, 14, 15);
    else if constexpr (Q == 2) return __builtin_shufflevector(X, w, 0, 1, 2, 3, 4, 5, 6, 7, 16, 17, 18, 19, 12, 13, 14, 15);
    else return __builtin_shufflevector(X, w, 0, 1, 2, 3, 4, 5, 6, 7, 8, 9, 10, 11, 16, 17, 18, 19);
}
__device__ __forceinline__ void glds16_s(const char* sbase, const unsigned voff, const unsigned lds_dst) {
    unsigned keep;
    asm volatile("s_mov_b32 %0, m0\n\ts_mov_b32 m0, %3\n\ts_nop 0\n\tglobal_load_lds_dwordx4 %1, %2\n\ts_mov_b32 m0, %0" : "=&s"(keep) : "v"(voff), "s"(sbase), "s"(lds_dst) : "memory");
}
__device__ __forceinline__ void tile_order(int wgid, int nM, int nN, int& pm, int& pn) {
    const int nwg = nM * nN; { const int q = nwg / NXCD, r = nwg % NXCD, xcd = wgid % NXCD, off = wgid / NXCD; wgid = (xcd < r ? xcd * (q + 1) : r * (q + 1) + (xcd - r) * q) + off; }
    const int nig = WGM * nN, gid = wgid / nig, fm = gid * WGM, gsz = (nM - fm) < WGM ? (nM - fm) : WGM;
    pm = fm + ((wgid % nig) % gsz); pn = (wgid % nig) / gsz;
}

struct NoMid { };
template <class T, class = void> struct EpiHasPf { static constexpr bool v = false; };
template <class T> struct EpiHasPf<T, decltype((void)T::HAS_PF)> { static constexpr bool v = true; };
constexpr int EPF_OFF = RING_BYTES;
template <class Epi, class Sched, bool GATHER, bool FP8 = false, bool ATILED = false, bool CADJ = false, class Mid = NoMid>
__device__ __forceinline__ void gemm_phase(LAS unsigned char* lds, const int wid, const int lda, const int ldb, const int K, const Sched& S, const Epi& E, const Mid& MH = Mid{}) {
    const int lane = fresh_lane(), tid = wid * 64 + lane, wr = wid >> 2, wc = wid & 3, fr = lane & 15, fq = lane >> 4;
    const int nt = K / BK;
    unsigned vA0[2], vA1[2], voffB[2];
#pragma unroll
    for (int i = 0; i < 2; ++i) { int R, C; stage_rc(tid * 16 + i * 8192, R, C); const int Rb = (R & ~31) + perm32(R & 31);
        if constexpr (ATILED) { vA0[i] = (unsigned)((C >> 3) * 4096 + R * 16); vA1[i] = vA0[i] + 2048u; }
        else { vA0[i] = (unsigned)(R * lda + C) * 2u; vA1[i] = vA0[i] + (unsigned)(HALF * lda) * 2u; }
        if constexpr (CADJ) voffB[i] = (unsigned)((64 * ((Rb >> 5) & 3) + 16 * ((Rb >> 3) & 3) + (Rb & 7)) * ldb + C) * 2u; else voffB[i] = (unsigned)(Rb * ldb + C) * 2u; }
    const size_t kstep = (size_t)(BK * 2), kstepA = ATILED ? (size_t)32768 : kstep;
    const size_t hstepB = CADJ ? (size_t)8 * ldb * 2 : (size_t)HALF * ldb * 2;
    const unsigned ldsw = (unsigned)wid * 1024u;
    const int aoff = lds_byte(wr * 64 + fr, fq * 8), boff = lds_byte(wc * 32 + fr, fq * 8);
#define PG8_SA(b, h) (((b) * 2 + (h)) * HTB)
#define PG8_SB(b, h) ((4 + (b) * 2 + (h)) * HTB)
#define PG8_STAGE(bufoff, gbase, voff) do { _Pragma("unroll") for (int _i = 0; _i < 2; ++_i) \
        glds16_s((const char*)(gbase), (voff)[_i], (unsigned)(uintptr_t)(lds + (bufoff) + ldsw + _i * 8192)); } while (0)
#define PG8_LDA(dst, b, h) do { _Pragma("unroll") for (int m = 0; m < 4; ++m) dst[m] = cat8(*(const LAS bf16x8*)(lds + PG8_SA(b, h) + aoff + m * 2048), *(const LAS bf16x8*)(lds + PG8_SA(b, h) + aoff + m * 2048 + 1024)); } while (0)
#define PG8_LDB(dst, b, h) do { _Pragma("unroll") for (int n = 0; n < 2; ++n) dst[n] = cat8(*(const LAS bf16x8*)(lds + PG8_SB(b, h) + boff + n * 2048), *(const LAS bf16x8*)(lds + PG8_SB(b, h) + boff + n * 2048 + 1024)); } while (0)
#define PG8_Q(X, q) ((f32x4)__builtin_shufflevector(X, X, 4 * (q), 4 * (q) + 1, 4 * (q) + 2, 4 * (q) + 3))
#define PG8_MM1(X, q, m, n, At, Bt) do { f32x4 c_ = PG8_Q(X, q); \
        if constexpr (FP8) c_ = __builtin_amdgcn_mfma_scale_f32_16x16x128_f8f6f4(Bt[n], At[m], c_, 0, 0, 0, 0x7f7f7f7f, 0, 0x7f7f7f7f); \
        else { c_ = __builtin_amdgcn_mfma_f32_16x16x32_bf16(lo8(Bt[n]), lo8(At[m]), c_, 0, 0, 0); c_ = __builtin_amdgcn_mfma_f32_16x16x32_bf16(hi8(Bt[n]), hi8(At[m]), c_, 0, 0, 0); } \
        X = ins4<q>(X, c_); } while (0)
#define PG8_MMA(ai, bj, At, Bt) do { __builtin_amdgcn_s_setprio(1); \
        PG8_MM1(acc16[ai][bj][0], 0, 0, 0, At, Bt); PG8_MM1(acc16[ai][bj][0], 1, 0, 1, At, Bt); PG8_MM1(acc16[ai][bj][0], 2, 1, 0, At, Bt); PG8_MM1(acc16[ai][bj][0], 3, 1, 1, At, Bt); \
        PG8_MM1(acc16[ai][bj][1], 0, 2, 0, At, Bt); PG8_MM1(acc16[ai][bj][1], 1, 2, 1, At, Bt); PG8_MM1(acc16[ai][bj][1], 2, 3, 0, At, Bt); PG8_MM1(acc16[ai][bj][1], 3, 3, 1, At, Bt); \
        __builtin_amdgcn_s_setprio(0); } while (0)
#define PG8_WAIT_V(n) asm volatile("s_waitcnt vmcnt(" #n ")" ::: "memory")
#define PG8_WAIT_L(n) asm volatile("s_waitcnt lgkmcnt(" #n ")" ::: "memory")
#define PG8_BAR __builtin_amdgcn_s_barrier()
#define PG8_SCHED __builtin_amdgcn_sched_barrier(0)
#define PG8_GIDX(dst0, dst1, u) do { const int R0_ = (wid >> 1) * 16 + (lane >> 2); const unsigned Cb_ = (unsigned)(((wid & 1) * 32 + (((lane & 3) * 8) ^ (((lane >> 5) & 1) << 4))) * 2); \
        _Pragma("unroll") for (int _i = 0; _i < 2; ++_i) { dst0[_i] = (unsigned)(u).idx[R0_ + 64 * _i] * (unsigned)(lda * 2) + Cb_; dst1[_i] = (unsigned)(u).idx[HALF + R0_ + 64 * _i] * (unsigned)(lda * 2) + Cb_; } } while (0)
    GUnit cur, nxt; int ui = 0;
    if (!S.next(0, cur)) return;
    f32x16 acc16[2][2][2];
#define PG8_ZERO() do { _Pragma("unroll") for (int a = 0; a < 2; ++a) _Pragma("unroll") for (int b = 0; b < 2; ++b) _Pragma("unroll") for (int h = 0; h < 2; ++h) _Pragma("unroll") for (int r = 0; r < 16; ++r) acc16[a][b][h][r] = 0.f; } while (0)
    PG8_ZERO();
    v8i_t At[4], B0[2], B1[2];
    const char* cA = cur.A; const char* cB = cur.B;
    int pfs = 0;
    if constexpr (EpiHasPf<Epi>::v) { const float v0_ = E.pf_load(cur, tid, wid); ((LAS float*)(lds + EPF_OFF))[tid] = v0_; }
    if constexpr (GATHER) { PG8_GIDX(vA0, vA1, cur); VM_WAIT(); }
    PG8_STAGE(PG8_SB(0, 0), cB, voffB); PG8_STAGE(PG8_SB(0, 1), cB + hstepB, voffB); PG8_STAGE(PG8_SA(0, 0), cA, vA0); PG8_STAGE(PG8_SA(0, 1), cA, vA1);
    if (wr == 1) PG8_BAR;
    PG8_WAIT_V(2); PG8_BAR;
    PG8_STAGE(PG8_SB(1, 0), cB + kstep, voffB); PG8_STAGE(PG8_SA(1, 0), cA + kstepA, vA0); PG8_STAGE(PG8_SB(1, 1), cB + hstepB + kstep, voffB);
    PG8_WAIT_V(6); PG8_BAR;
    for (;;) {
        const bool has_next = S.next(ui + 1, nxt);
        const char* nA = has_next ? nxt.A : cA; const char* nB = has_next ? nxt.B : cB;
#pragma unroll 1
        for (int t = 0; t < nt; t += 2) {
            const bool last = (t == nt - 2);
            if constexpr (!__is_same(Mid, NoMid)) { if (t == (nt >> 1)) MH(acc16, cur, wr, wc, fr, fq); }
            const char* a1 = cA + (size_t)(t + 1) * kstepA;
            const char* a2 = last ? nA : cA + (size_t)(t + 2) * kstepA; const char* b2 = last ? nB : cB + (size_t)(t + 2) * kstep;
            const char* a3 = a2 + kstepA; const char* b3 = b2 + kstep;
            PG8_LDB(B0, 0, 0); PG8_LDB(B1, 0, 1); PG8_SCHED; PG8_LDA(At, 0, 0); PG8_STAGE(PG8_SA(1, 1), a1, vA1);
            if constexpr (GATHER) { if (last && has_next) PG8_GIDX(vA0, vA1, nxt); }
            PG8_WAIT_V(8); PG8_WAIT_L(0); PG8_BAR; PG8_MMA(0, 0, At, B0); PG8_MMA(0, 1, At, B1); PG8_BAR; PG8_SCHED;
            PG8_LDA(At, 0, 1); PG8_STAGE(PG8_SB(0, 0), b2, voffB); PG8_STAGE(PG8_SB(0, 1), b2 + hstepB, voffB); PG8_STAGE(PG8_SA(0, 0), a2, vA0);
            PG8_WAIT_V(8); PG8_WAIT_L(0); PG8_BAR; PG8_MMA(1, 0, At, B0); PG8_MMA(1, 1, At, B1); PG8_BAR; PG8_SCHED;
            PG8_LDB(B0, 1, 0); PG8_LDB(B1, 1, 1); PG8_SCHED; PG8_LDA(At, 1, 0); PG8_STAGE(PG8_SA(0, 1), a2, vA1);
            PG8_WAIT_V(8); PG8_WAIT_L(0); PG8_BAR; PG8_MMA(0, 0, At, B0); PG8_MMA(0, 1, At, B1); PG8_BAR; PG8_SCHED;
            PG8_LDA(At, 1, 1); PG8_STAGE(PG8_SB(1, 0), b3, voffB); PG8_STAGE(PG8_SB(1, 1), b3 + hstepB, voffB); PG8_STAGE(PG8_SA(1, 0), a3, vA0);
            PG8_WAIT_V(8); PG8_WAIT_L(0); PG8_BAR; PG8_MMA(1, 0, At, B0); PG8_MMA(1, 1, At, B1); PG8_BAR; PG8_SCHED;
        }
        float pfv = 0.f;
        if constexpr (EpiHasPf<Epi>::v) { if (has_next) pfv = E.pf_load_async(nxt, tid, wid); }
        if (wr == 0) PG8_BAR;
        { f32x4 acc[2][2][4][2];
#pragma unroll
          for (int a = 0; a < 2; ++a)
#pragma unroll
              for (int b = 0; b < 2; ++b)
#pragma unroll
                  for (int m = 0; m < 4; ++m)
#pragma unroll
                      for (int n = 0; n < 2; ++n)
#pragma unroll
                          for (int j = 0; j < 4; ++j) acc[a][b][m][n][j] = acc16[a][b][m >> 1][((m & 1) * 2 + n) * 4 + j];
          if constexpr (EpiHasPf<Epi>::v) E.run(acc, cur, wr, wc, fr, fq, (const LAS float*)(lds + EPF_OFF + pfs * 2048)); else E(acc, cur, wr, wc, fr, fq); }
        if constexpr (EpiHasPf<Epi>::v) { if (has_next) { E.pf_wait(pfv); ((LAS float*)(lds + EPF_OFF + (pfs ^ 1) * 2048))[tid] = pfv; pfs ^= 1; } }
        if (!has_next) break;
        PG8_ZERO();
        cur = nxt; cA = nA; cB = nB; ++ui;
        if (wr == 1) PG8_BAR;
    }
    PG8_WAIT_V(0);
    PG8_BAR;
#undef PG8_SA
#undef PG8_SB
#undef PG8_STAGE
#undef PG8_LDA
#undef PG8_LDB
#undef PG8_MMA
#undef PG8_WAIT_V
#undef PG8_WAIT_L
#undef PG8_BAR
#undef PG8_SCHED
#undef PG8_GIDX
#undef PG8_ZERO
#undef PG8_Q
#undef PG8_MM1
}
}
using pg8::GUnit;
enum { K_Q = 0, K_K = 1, K_U = 2, K_GA = 3, K_GS = 4, K_VT = 5, K_XK = 6, K_XVT = 7 };
typedef f32x4 Acc[2][2][4][2];

__device__ __forceinline__ u32x4 pack8(const f32x4 a, const f32x4 b) { u32x4 w; w.x = cvt_pk_bf16(a[0], a[1]); w.y = cvt_pk_bf16(a[2], a[3]); w.z = cvt_pk_bf16(b[0], b[1]); w.w = cvt_pk_bf16(b[2], b[3]); return w; }
__device__ __forceinline__ void unpack8(const u32x4 w, f32x4& a, f32x4& b) { a = (f32x4){bf_lo(w.x), bf_hi(w.x), bf_lo(w.y), bf_hi(w.y)}; b = (f32x4){bf_lo(w.z), bf_hi(w.z), bf_lo(w.w), bf_hi(w.w)}; }
__device__ __forceinline__ f32x4 sig4(const f32x4 v) { return (f32x4){fast_sigmoid(v[0]), fast_sigmoid(v[1]), fast_sigmoid(v[2]), fast_sigmoid(v[3])}; }
__device__ __forceinline__ void store_pair16(bf16_t* blk, const size_t ld, const u32x4 c0, const u32x4 c1, const int k0, const int k1, const int fr) {
    u32x4 r1, dA, dB; const bool lo = fr < 8;
#pragma unroll
    for (int k = 0; k < 4; ++k) { r1[k] = (unsigned)__builtin_amdgcn_update_dpp(0, (int)c1[k], 0x128  , 0xF, 0xF, false); dA[k] = lo ? c0[k] : r1[k]; dB[k] = lo ? r1[k] : c0[k]; }
    *(u32x4*)(blk + (size_t)(fr & 7) * ld + (lo ? k0 : k1) * 8) = dA;
    *(u32x4*)(blk + (size_t)(8 + (fr & 7)) * ld + (lo ? k1 : k0) * 8) = dB;
}
__device__ __forceinline__ float row_rstd16(const float* ssp, int row) {
    const f32x4* p = (const f32x4*)(ssp + (size_t)row * 16); const f32x4 a = p[0], b = p[1], c = p[2], d = p[3];
    const float s = ((a[0] + a[1]) + (a[2] + a[3])) + ((b[0] + b[1]) + (b[2] + b[3])) + ((c[0] + c[1]) + (c[2] + c[3])) + ((d[0] + d[1]) + (d[2] + d[3]));
    return __builtin_amdgcn_rsqf(s * (1.0f / DM) + EPS);
}

constexpr float GATE_TINY_P1 = 9.094947017729282e-13f;
struct EpiP1 {
    unsigned char* ws; const float* rstd0; const float* rope;
    __device__ __forceinline__ void operator()(const Acc& acc, const GUnit& u, int wr, int wc, int fr, int fq) const {
        const int kind = u.kind, row0 = u.pm * 256 + wr * 64 + fr;
        if (kind <= K_K) {
            bf16_t* O = (bf16_t*)(ws + ((kind == K_Q) ? WS_Q : WS_K)); const float sc = (kind == K_Q) ? QSCALE : 1.0f;
            const int cb = (u.pn & 1) * 256 + wc * 64 + fq * 8;
#pragma unroll
            for (int ai = 0; ai < 2; ++ai) {
                float rsv[4]; f32x4 rq[4][4];
#pragma unroll
                for (int m = 0; m < 4; ++m) { const int row = row0 + ai * 128 + m * 16; rsv[m] = rstd0[row];
                    const f32x4* rp = (const f32x4*)(rope + ((size_t)(row & (SEQ - 1)) * 32 + fq * 8) * 2); rq[m][0] = rp[0]; rq[m][1] = rp[1]; rq[m][2] = rp[2]; rq[m][3] = rp[3]; }
                __builtin_amdgcn_sched_barrier(0);
#pragma unroll
                for (int m = 0; m < 4; ++m) {
                    const int row = row0 + ai * 128 + m * 16; const float rs = rsv[m] * sc;
                    const f32x4 r0 = rq[m][0], r1 = rq[m][1], r2 = rq[m][2], r3 = rq[m][3];
                    const f32x4 a0 = acc[ai][0][m][0] * rs, a1 = acc[ai][0][m][1] * rs, b0 = acc[ai][1][m][0] * rs, b1 = acc[ai][1][m][1] * rs;
                    const f32x4 c0 = (f32x4){r0[0], r0[2], r1[0], r1[2]}, s0 = (f32x4){r0[1], r0[3], r1[1], r1[3]}, c1 = (f32x4){r2[0], r2[2], r3[0], r3[2]}, s1 = (f32x4){r2[1], r2[3], r3[1], r3[3]};
                    const f32x4 o1a = a0 * c0 - b0 * s0, o1b = a1 * c1 - b1 * s1, o2a = b0 * c0 + a0 * s0, o2b = b1 * c1 + a1 * s1;
                    store_pair16(O + (size_t)(row - fr) * 512 + (u.pn & 1) * 256 + wc * 64, 512, pack8(o1a, o1b), pack8(o2a, o2b), fq, 4 + fq, fr);
                }
            }
        } else if (kind <= K_GS) {
            int cb, ld; size_t wo;
            if (kind == K_U) { wo = WS_U; cb = (u.pn - 4) * 256 + wc * 64; ld = 512; } else { wo = WS_GA; cb = (u.pn - 6) * 128 + wc * 32 + fq * 8; ld = 1024; }
            bf16_t* O = (bf16_t*)(ws + wo);
            float rsv[8];
#pragma unroll
            for (int i = 0; i < 8; ++i) rsv[i] = rstd0[row0 + (i >> 2) * 128 + (i & 3) * 16] * (kind == K_U ? 1.0f : W8INV);
            __builtin_amdgcn_sched_barrier(0);
#pragma unroll
            for (int ai = 0; ai < 2; ++ai)
#pragma unroll
                for (int m = 0; m < 4; ++m) {
                    const int row = row0 + ai * 128 + m * 16; const float rs = rsv[ai * 4 + m]; u32x4 ch[2];
                    if (kind == K_U) {
#pragma unroll
                        for (int bj = 0; bj < 2; ++bj) ch[bj] = pack8(acc[ai][bj][m][0] * rs, acc[ai][bj][m][1] * rs);
                        store_pair16(O + (size_t)(row - fr) * ld + cb, ld, ch[0], ch[1], 2 * fq, 2 * fq + 1, fr);
                    } else {
                        f32x4 a0 = sig4(acc[ai][0][m][0] * rs), a1 = sig4(acc[ai][0][m][1] * rs), s0 = sig4(acc[ai][1][m][0] * rs), s1 = sig4(acc[ai][1][m][1] * rs);
#pragma unroll
                        for (int j = 0; j < 4; ++j) { s0[j] = fmaxf(s0[j], GATE_TINY_P1); s1[j] = fmaxf(s1[j], GATE_TINY_P1);
                            a0[j] = fmaxf(a0[j], GATE_TINY_P1) * __builtin_amdgcn_rcpf(s0[j]); a1[j] = fmaxf(a1[j], GATE_TINY_P1) * __builtin_amdgcn_rcpf(s1[j]); }
                        *(u32x4*)(O + (size_t)row * 1024 + cb) = pack8(a0, a1); *(u32x4*)((bf16_t*)(ws + WS_GS) + (size_t)row * 1024 + cb) = pack8(s0, s1);
                    }
                }
        } else {
            bf16_t* O = (bf16_t*)(ws + ((kind == K_VT) ? WS_VT : (kind == K_XK ? WS_XK : WS_XVT))); const int ld = (kind == K_VT) ? NTOK : (kind == K_XK ? 1024 : NMEMTOK);
            const int cb = u.pn * 256 + wc * 64 + fq * 16;
            f32x4 cs[2][2];
#pragma unroll
            for (int bj = 0; bj < 2; ++bj) { if (kind == K_VT) { cs[bj][0] = *(const f32x4*)(rstd0 + cb + bj * 8); cs[bj][1] = *(const f32x4*)(rstd0 + cb + bj * 8 + 4); } else { cs[bj][0] = (f32x4){W8INV, W8INV, W8INV, W8INV}; cs[bj][1] = cs[bj][0]; } }
#pragma unroll
            for (int ai = 0; ai < 2; ++ai)
#pragma unroll
                for (int m = 0; m < 4; ++m) {
                    const int row = row0 + ai * 128 + m * 16;
                    store_pair16(O + (size_t)(row - fr) * ld + u.pn * 256 + wc * 64, ld, pack8(acc[ai][0][m][0] * cs[0][0], acc[ai][0][m][1] * cs[0][1]), pack8(acc[ai][1][m][0] * cs[1][0], acc[ai][1][m][1] * cs[1][1]), 2 * fq, 2 * fq + 1, fr);
                }
        }
    }
};
struct EpiGlu {
    bf16_t* OAS; float asc = 1.0f;
    __device__ __forceinline__ void operator()(const Acc& acc, const GUnit& u, int wr, int wc, int fr, int fq) const {
        const int row0 = u.pm * 256 + wr * 64 + fr, cb = 512 + u.pn * 128 + wc * 32 + fq * 8;
#pragma unroll
        for (int ai = 0; ai < 2; ++ai)
#pragma unroll
            for (int m = 0; m < 4; ++m) { const int row = row0 + ai * 128 + m * 16;
                *(u32x4*)(OAS + (size_t)row * 1024 + cb) = pack8(acc[ai][0][m][0] * asc * sig4(acc[ai][1][m][0] * asc), acc[ai][0][m][1] * asc * sig4(acc[ai][1][m][1] * asc)); }
    }
};
#ifndef PROBE_PITCH
#define PROBE_PITCH 1024
#endif
template <int MODE> struct EpiProbe {
    bf16_t* OAS;
    __device__ __forceinline__ void operator()(const Acc& acc, const GUnit& u, int wr, int wc, int fr, int fq) const {
        const int row0 = u.pm * 256 + wr * 64 + fr, cb = 512 + u.pn * 128 + wc * 32 + fq * 8;
        if (MODE == 3) {
#pragma unroll
            for (int ai = 0; ai < 2; ++ai)
#pragma unroll
                for (int m = 0; m < 4; ++m)
#pragma unroll
                    for (int hh = 0; hh < 2; ++hh) { const int row = u.pm * 256 + wr * 64 + ai * 128 + m * 16 + hh * 8 + (fr & 7), cc = 512 + u.pn * 128 + ((wc >> 1) * 64) + (fq * 2 + (fr >> 3)) * 8;
                        if ((wc & 1) == hh) *(u32x4*)(OAS + (size_t)row * PROBE_PITCH + cc) = pack8(acc[ai][0][m][0] + acc[ai][1][m][0], acc[ai][0][m][1] + acc[ai][1][m][1]); }
        } else if (MODE == 1) {
#pragma unroll
            for (int ai = 0; ai < 2; ++ai)
#pragma unroll
                for (int m = 0; m < 4; ++m) { const int row = row0 + ai * 128 + m * 16;
                    *(u32x4*)(OAS + (size_t)row * PROBE_PITCH + cb) = pack8(acc[ai][0][m][0] + acc[ai][1][m][0], acc[ai][0][m][1] + acc[ai][1][m][1]); }
        } else { f32x4 s = (f32x4){0.f, 0.f, 0.f, 0.f};
#pragma unroll
            for (int ai = 0; ai < 2; ++ai)
#pragma unroll
                for (int bj = 0; bj < 2; ++bj)
#pragma unroll
                    for (int m = 0; m < 4; ++m) s += acc[ai][bj][m][0] + acc[ai][bj][m][1];
            if (s[0] + s[1] + s[2] + s[3] == 123456.789f) OAS[(size_t)row0 * 1024 + cb] = 1; }
    }
};
template <int MODE> struct EpiBranch {
    const bf16_t* G; const bf16_t* P; bf16_t* O;
    __device__ __forceinline__ void operator()(const Acc& acc, const GUnit& u, int wr, int wc, int fr, int fq) const {
        const int row0 = u.pm * 256 + wr * 64 + fr, cb = u.pn * 256 + wc * 64 + fq * 16;
#pragma unroll
        for (int ai = 0; ai < 2; ++ai) {
            u32x4 gw[4][2], pw[4][2];
#pragma unroll
            for (int m = 0; m < 4; ++m)
#pragma unroll
                for (int bj = 0; bj < 2; ++bj) { const size_t off = (size_t)(row0 + ai * 128 + m * 16) * 1024 + cb + bj * 8; gw[m][bj] = *(const u32x4*)(G + off); if (MODE == 1) pw[m][bj] = *(const u32x4*)(P + off); }
            __builtin_amdgcn_sched_barrier(0);
#pragma unroll
            for (int m = 0; m < 4; ++m) { u32x4 ch[2];
#pragma unroll
                for (int bj = 0; bj < 2; ++bj) { f32x4 g0, g1; unpack8(gw[m][bj], g0, g1);
                    f32x4 v0 = g0 * acc[ai][bj][m][0], v1 = g1 * acc[ai][bj][m][1];
                    if (MODE == 1) { f32x4 p0, p1; unpack8(pw[m][bj], p0, p1); v0 += p0; v1 += p1; }
                    ch[bj] = pack8(v0, v1); }
                store_pair16(O + (size_t)(row0 - fr + ai * 128 + m * 16) * 1024 + u.pn * 256 + wc * 64, 1024, ch[0], ch[1], 2 * fq, 2 * fq + 1, fr); }
        }
    }
};
constexpr float GATE_TINY = 9.094947017729282e-13f;
template <int MCH> struct MidGateT {
    const bf16_t* GA; const bf16_t* GS;
    __device__ __forceinline__ void operator()(f32x16 (&acc16)[2][2][2], const GUnit& u, int wr, int wc, int fr, int fq) const {
        const unsigned vo = (unsigned)((u.pm * 256 + wr * 64 + fr) * 1024 + u.pn * 256 + wc * 64 + fq * 16) * 2u;
        const char* ga_ = (const char*)GA;
#pragma unroll
        for (int ai = 0; ai < 2; ++ai)
#pragma unroll
            for (int mc = 0; mc < 4; mc += MCH) { u32x4 ga[MCH][2];
                unsigned vq = vo + (unsigned)((ai * 128 + mc * 16) * 2048); asm volatile("" : "+v"(vq));
#pragma unroll
                for (int mm = 0; mm < MCH; ++mm)
#pragma unroll
                    for (int bj = 0; bj < 2; ++bj) { const unsigned off = vq + (unsigned)(mm * 16 * 2048 + bj * 16); ga[mm][bj] = *(const u32x4*)(ga_ + off); }
                __builtin_amdgcn_sched_barrier(0);
#pragma unroll
                for (int mm = 0; mm < MCH; ++mm) { const int m = mc + mm;
#pragma unroll
                    for (int bj = 0; bj < 2; ++bj) { f32x4 g0, g1; unpack8(ga[mm][bj], g0, g1);
#pragma unroll
                        for (int j = 0; j < 4; ++j) { acc16[ai][bj][m >> 1][((m & 1) * 2 + 0) * 4 + j] *= g0[j]; acc16[ai][bj][m >> 1][((m & 1) * 2 + 1) * 4 + j] *= g1[j]; } } }
                __builtin_amdgcn_sched_barrier(0);
            }
    }
};
#ifndef MID_MCH
#define MID_MCH 4
#endif
typedef MidGateT<MID_MCH> MidGate;
struct EpiGateOut {
    const bf16_t* GS; bf16_t* O;
    __device__ __forceinline__ void operator()(const Acc& acc, const GUnit& u, int wr, int wc, int fr, int fq) const {
        const int row0 = u.pm * 256 + wr * 64 + fr, cb = u.pn * 256 + wc * 64 + fq * 16;
        u32x4 gw[2][4][2];
#pragma unroll
        for (int ai = 0; ai < 2; ++ai)
#pragma unroll
            for (int m = 0; m < 4; ++m)
#pragma unroll
                for (int bj = 0; bj < 2; ++bj) gw[ai][m][bj] = *(const u32x4*)(GS + (size_t)(row0 + ai * 128 + m * 16) * 1024 + cb + bj * 8);
        __builtin_amdgcn_sched_barrier(0);
#pragma unroll
        for (int ai = 0; ai < 2; ++ai) {
#pragma unroll
            for (int m = 0; m < 4; ++m) { u32x4 ch[2];
#pragma unroll
                for (int bj = 0; bj < 2; ++bj) { f32x4 g0, g1; unpack8(gw[ai][m][bj], g0, g1);
                    ch[bj] = pack8(g0 * acc[ai][bj][m][0], g1 * acc[ai][bj][m][1]); }
                store_pair16(O + (size_t)(row0 - fr + ai * 128 + m * 16) * 1024 + u.pn * 256 + wc * 64, 1024, ch[0], ch[1], 2 * fq, 2 * fq + 1, fr); }
        }
    }
};
template <bool BASE_F32, bool WITH8 = !BASE_F32> struct EpiResid {
    const void* base; bf16_t* O; float* ssp; unsigned char* O8; float asc = 1.0f;
    static_assert(!BASE_F32, "the residual base is a bf16 tensor");
    __device__ __forceinline__ void operator()(const Acc& acc, const GUnit& u, int wr, int wc, int fr, int fq) const {
        const int row0 = u.pm * 256 + wr * 64 + fr, cb = u.pn * 256 + wc * 64 + fq * 16;
        u32x4 bw[2][4][2];
#pragma unroll
        for (int ai = 0; ai < 2; ++ai)
#pragma unroll
            for (int m = 0; m < 4; ++m)
#pragma unroll
                for (int bj = 0; bj < 2; ++bj) bw[ai][m][bj] = *(const u32x4*)((const bf16_t*)base + (size_t)(row0 + ai * 128 + m * 16) * 1024 + cb + bj * 8);
        __builtin_amdgcn_sched_barrier(0);
#pragma unroll
        for (int ai = 0; ai < 2; ++ai) {
#pragma unroll
            for (int m = 0; m < 4; ++m) { const int row = row0 + ai * 128 + m * 16; const size_t off = (size_t)row * 1024 + cb; float s = 0.f; u32x4 ch[2];
#pragma unroll
                for (int bj = 0; bj < 2; ++bj) { f32x4 b0, b1; unpack8(bw[ai][m][bj], b0, b1);
                    const f32x4 v0 = b0 + acc[ai][bj][m][0] * asc, v1 = b1 + acc[ai][bj][m][1] * asc;
                    s += (v0[0] * v0[0] + v0[1] * v0[1]) + (v0[2] * v0[2] + v0[3] * v0[3]) + (v1[0] * v1[0] + v1[1] * v1[1]) + (v1[2] * v1[2] + v1[3] * v1[3]);
                    ch[bj] = pack8(v0, v1);
                    if (WITH8) *(u32x2*)(O8 + off + bj * 8) = (u32x2){pack4_fp8(v0[0], v0[1], v0[2], v0[3]), pack4_fp8(v1[0], v1[1], v1[2], v1[3])}; }
                store_pair16(O + (size_t)(row - fr) * 1024 + u.pn * 256 + wc * 64, 1024, ch[0], ch[1], 2 * fq, 2 * fq + 1, fr);
                s += __shfl_xor(s, 16); s += __shfl_xor(s, 32);
                if (fq == 0) ssp[(size_t)row * 16 + u.pn * 4 + wc] = s; }
        }
    }
};
struct EpiXq {
    bf16_t* O; const float* ssp;
    __device__ __forceinline__ void operator()(const Acc& acc, const GUnit& u, int wr, int wc, int fr, int fq) const {
        const int row0 = u.pm * 256 + wr * 64 + fr;
#pragma unroll
        for (int ai = 0; ai < 2; ++ai) {
            f32x4 sp[4][4];
#pragma unroll
            for (int m = 0; m < 4; ++m) { const f32x4* p = (const f32x4*)(ssp + (size_t)(row0 + ai * 128 + m * 16) * 16); sp[m][0] = p[0]; sp[m][1] = p[1]; sp[m][2] = p[2]; sp[m][3] = p[3]; }
            __builtin_amdgcn_sched_barrier(0);
#pragma unroll
            for (int m = 0; m < 4; ++m) { const int row = row0 + ai * 128 + m * 16; const f32x4 a = sp[m][0], b = sp[m][1], c = sp[m][2], d = sp[m][3];
                const float sm = ((a[0] + a[1]) + (a[2] + a[3])) + ((b[0] + b[1]) + (b[2] + b[3])) + ((c[0] + c[1]) + (c[2] + c[3])) + ((d[0] + d[1]) + (d[2] + d[3]));
                const float rs = __builtin_amdgcn_rsqf(sm * (1.0f / DM) + EPS) * (XQSCALE * W8INV);
                store_pair16(O + (size_t)(row - fr) * 1024 + u.pn * 256 + wc * 64, 1024, pack8(acc[ai][0][m][0] * rs, acc[ai][0][m][1] * rs), pack8(acc[ai][1][m][0] * rs, acc[ai][1][m][1] * rs), 2 * fq, 2 * fq + 1, fr); }
        }
    }
};
struct EpiE1 {
    unsigned char* ACT; const float* rscale; const float* b1;
    __device__ __forceinline__ void operator()(const Acc& acc, const GUnit& u, int wr, int wc, int fr, int fq) const {
        const int row0 = u.pm * 256 + wr * 64 + fr, cc = u.pn * 128 + wc * 32 + fq * 8; const float* bb = b1 + (size_t)u.e * 2048 + cc;
        const f32x4 bg0 = *(const f32x4*)bb, bg1 = *(const f32x4*)(bb + 4), bl0 = *(const f32x4*)(bb + 1024), bl1 = *(const f32x4*)(bb + 1028);
        unsigned char* abase = ACT + (size_t)u.pm * 262144 + u.pn * 32768; const unsigned alo = (unsigned)((2 * wc + (fq >> 1)) * 4096 + (fq & 1) * 8 + (wr * 64 + fr) * 16);
        float rsv[8];
#pragma unroll
        for (int i = 0; i < 8; ++i) rsv[i] = rscale[u.kind + wr * 64 + fr + (i >> 2) * 128 + (i & 3) * 16] * W8INV;
        constexpr float KS = 1.702f * LOG2E, KI = 1.0f / KS;
        const f32x4 bgk0 = bg0 * -KS, bgk1 = bg1 * -KS, blk0 = (bl0 + 1.0f) * -KI, blk1 = (bl1 + 1.0f) * -KI;
        __builtin_amdgcn_sched_barrier(0);
#pragma unroll
        for (int ai = 0; ai < 2; ++ai)
#pragma unroll
            for (int m = 0; m < 4; ++m) { const float rs = rsv[ai * 4 + m], rsg = rs * -KS, rsl = rs * -KI;
                f32x4 g0 = acc[ai][0][m][0] * rsg + bgk0, g1 = acc[ai][0][m][1] * rsg + bgk1, l0 = acc[ai][1][m][0] * rsl + blk0, l1 = acc[ai][1][m][1] * rsl + blk1, d0, d1, o0, o1;
#pragma unroll
                for (int j = 0; j < 4; ++j) { g0[j] = fmaxf(g0[j], -7.0f * KS); g1[j] = fmaxf(g1[j], -7.0f * KS); l0[j] = fminf(fmaxf(l0[j], -8.0f * KI), 6.0f * KI); l1[j] = fminf(fmaxf(l1[j], -8.0f * KI), 6.0f * KI);
                    d0[j] = __builtin_amdgcn_exp2f(g0[j]); d1[j] = __builtin_amdgcn_exp2f(g1[j]); }
                d0 = d0 + 1.0f; d1 = d1 + 1.0f; g0 = g0 * l0; g1 = g1 * l1;
#pragma unroll
                for (int j = 0; j < 4; ++j) { d0[j] = __builtin_amdgcn_rcpf(d0[j]); d1[j] = __builtin_amdgcn_rcpf(d1[j]); }
                o0 = g0 * d0; o1 = g1 * d1;
                *(u32x2*)(abase + alo + (unsigned)((ai * 128 + m * 16) * 16)) = (u32x2){pack4_fp8(o0[0], o0[1], o0[2], o0[3]), pack4_fp8(o1[0], o1[1], o1[2], o1[3])}; }
    }
};
__device__ __forceinline__ float pf_ld32(const float* base, const unsigned voff) { float v; asm volatile("global_load_dword %0, %1, %2" : "=v"(v) : "v"(voff), "s"(base) : "memory"); return v; }
struct EpiE2 {
    unsigned char* YS; const float* roww; const float* b2;
    static constexpr bool HAS_PF = true;
    __device__ __forceinline__ unsigned pf_off(const GUnit& u, const int tid) const { return (unsigned)(tid < 256 ? u.kind + tid : u.e * 1024 + u.pn * 256 + (tid - 256)) * 4u; }
    __device__ __forceinline__ float pf_load(const GUnit& u, const int tid, const int wid) const { return *(const float*)((const char*)(wid < 4 ? roww : b2) + pf_off(u, tid)); }
    __device__ __forceinline__ float pf_load_async(const GUnit& u, const int tid, const int wid) const { return pf_ld32(wid < 4 ? roww : b2, pf_off(u, tid)); }
    __device__ __forceinline__ void pf_wait(float& v) const { asm volatile("s_waitcnt vmcnt(8)" : "+v"(v) :: "memory"); }
    __device__ __forceinline__ void run(const Acc& acc, const GUnit& u, int wr, int wc, int fr, int fq, const LAS float* pf) const {
        const int row0 = u.pm * 256 + wr * 64 + fr, cb = u.pn * 256 + wc * 64 + fq * 16;
        f32x4 bv[2][2];
#pragma unroll
        for (int bj = 0; bj < 2; ++bj) { bv[bj][0] = *(const LAS f32x4*)(pf + 256 + wc * 64 + fq * 16 + bj * 8); bv[bj][1] = *(const LAS f32x4*)(pf + 256 + wc * 64 + fq * 16 + bj * 8 + 4); }
        float wv[8];
#pragma unroll
        for (int i = 0; i < 8; ++i) wv[i] = pf[wr * 64 + fr + (i >> 2) * 128 + (i & 3) * 16];
#pragma unroll
        for (int ai = 0; ai < 2; ++ai)
#pragma unroll
            for (int m = 0; m < 4; ++m) { const int row = row0 + ai * 128 + m * 16; const float w = wv[ai * 4 + m]; u32x4 pk;
#pragma unroll
                for (int bj = 0; bj < 2; ++bj) { const f32x4 v0 = (acc[ai][bj][m][0] * W8INV + bv[bj][0]) * w, v1 = (acc[ai][bj][m][1] * W8INV + bv[bj][1]) * w;
                    pk[2 * bj] = pack4_fp8(v0[0], v0[1], v0[2], v0[3]); pk[2 * bj + 1] = pack4_fp8(v1[0], v1[1], v1[2], v1[3]); }
                *(u32x4*)(YS + (size_t)row * 1024 + cb) = pk; }
    }
};

struct SimpleSched {
    const char* A; const char* B; size_t strideA, strideB; int nM, nN, G, c;
    __device__ __forceinline__ bool next(int i, GUnit& u) const {
        const long L = (long)i * G + c; if (L >= (long)nM * nN) return false;
        int pm, pn; pg8::tile_order((int)L, nM, nN, pm, pn);
        u.pm = pm; u.pn = pn; u.kind = 0; u.e = 0; u.idx = nullptr; u.A = A + (size_t)pm * strideA; u.B = B + (size_t)pn * strideB; return true;
    }
};
struct OneUnitSched {
    SimpleSched S; int i0;
    __device__ __forceinline__ bool next(int i, GUnit& u) const { return i == 0 && S.next(i0, u); }
};
struct P1Sched {
    const char *XB, *WIN, *MEMN, *WXK, *WXV; int G, c;
    __device__ __forceinline__ bool next(int i, GUnit& u) const {
        long L = (long)i * G + c; constexpr size_t TS = 256 * 1024 * 2; u.e = 0; u.idx = nullptr;
        if (L < 768) { int pm, pn; pg8::tile_order((int)L, 128, 6, pm, pn); u.pm = pm; u.pn = pn; u.A = XB + pm * TS; u.B = WIN + pn * TS; u.kind = pn < 2 ? K_Q : (pn < 4 ? K_K : K_U); return true; }
        L -= 768;
        if (L < 256) { u.pm = (int)(L >> 7); u.pn = (int)(L & 127); u.A = WIN + (size_t)(14 + u.pm) * TS; u.B = XB + u.pn * TS; u.kind = K_VT; return true; }
        L -= 256;
        return false;
    }
};
struct P1bSched {
    const char *XB8, *WIN8; int G, c;
    __device__ __forceinline__ bool next(int i, GUnit& u) const {
        const long L = (long)i * G + c; constexpr size_t TS = 256 * 1024; u.e = 0; u.idx = nullptr;
        if (L >= 1024) return false;
        int pm, pn; pg8::tile_order((int)L, 128, 8, pm, pn); u.pm = pm; u.pn = pn + 6; u.A = XB8 + pm * TS; u.B = WIN8 + (size_t)(pn + 2) * TS; u.kind = K_GA; return true;
    }
};
struct CrossSched {
    const char *MEMN, *WXK, *WXV; int G, c;
    __device__ __forceinline__ bool next(int i, GUnit& u) const {
        int L = i * G + c; if (L >= 128) return false;
        constexpr size_t TS = 256 * 1024; u.e = 0; u.idx = nullptr;
        if (L < 64) { u.pm = L >> 2; u.pn = L & 3; u.A = MEMN + u.pm * TS; u.B = WXK + u.pn * TS; u.kind = K_XK; return true; }
        L -= 64; u.pm = L >> 4; u.pn = L & 15; u.A = WXV + u.pm * TS; u.B = MEMN + u.pn * TS; u.kind = K_XVT; return true;
    }
};
struct GluSched {
    SimpleSched S;
    __device__ __forceinline__ bool next(int i, GUnit& u) const {
        if (S.G != 256) return S.next(i, u);
        if (S.c < 128) { if (i != 0) return false; } else if (i >= 3) return false;
        SimpleSched T = S; T.G = 128; T.c = S.c & 127; return T.next(S.c < 128 ? 0 : i + 1, u);
    }
};
struct MoeSched {
    const char* A; const char* W; const int* rowtok; const LAS int* blk_e; int nblk, NTN, G, c; size_t wstride  ; bool gather;
    __device__ __forceinline__ bool next(int i, GUnit& u) const {
        const int nx = (G % 8 == 0) ? 8 : 1, x = c % nx, r = c / nx, Wx = G / nx;
        const int b0 = (nblk * x) / nx, b1 = (nblk * (x + 1)) / nx;
        const long L = (long)i * Wx + r; if (L >= (long)(b1 - b0) * NTN) return false;
        const int blk = b0 + (int)(L / NTN), pn = (int)(L % NTN), e = __builtin_amdgcn_readfirstlane(blk_e[blk]);
        const int rb = e * MOE_CAP + (blk - __builtin_amdgcn_readfirstlane(blk_e[720 + e])) * 256;
        u.pm = blk; u.pn = pn; u.kind = rb; u.e = e; u.idx = rowtok + rb;
        u.A = gather ? A : A + (size_t)blk * 256 * 1024; u.B = W + (size_t)e * wstride + (size_t)pn * 256 * 1024; return true;
    }
};
#ifndef DA_BAL
#define DA_BAL 0
#endif
#ifndef DA_PRIO_ON
#define DA_PRIO_ON 0
#endif
#if DA_PRIO_ON
#define DA_PRIO(x) __builtin_amdgcn_s_setprio(x)
#else
#define DA_PRIO(x) do { } while (0)
#endif
#define KSWZ(row, colB) ((row) * 256 + ((colB) ^ (((row) & 7) << 4)))
__device__ __forceinline__ int crow(int r, int hi) { return (r & 3) + 8 * (r >> 2) + 4 * hi; }
#define PK4(P, BASE, OUT) do { unsigned a0 = cvt_pk_bf16(P[BASE + 0], P[BASE + 1]), a1 = cvt_pk_bf16(P[BASE + 2], P[BASE + 3]);   \
    unsigned b0 = cvt_pk_bf16(P[BASE + 4], P[BASE + 5]), b1 = cvt_pk_bf16(P[BASE + 6], P[BASE + 7]);                              \
    auto r0 = __builtin_amdgcn_permlane32_swap(a0, b0, false, false); auto r1 = __builtin_amdgcn_permlane32_swap(a1, b1, false, false); \
    u32x4 w = {r0[0], r1[0], r0[1], r1[1]}; OUT = *reinterpret_cast<bf16x8*>(&w); } while (0)
__device__ __forceinline__ float half_max(float v) { auto rr = __builtin_amdgcn_permlane32_swap(__float_as_uint(v), __float_as_uint(v), false, false); return fmaxf(__uint_as_float(rr[0]), __uint_as_float(rr[1])); }
__device__ __forceinline__ float half_sum(float v) { auto rr = __builtin_amdgcn_permlane32_swap(__float_as_uint(v), __float_as_uint(v), false, false); return __uint_as_float(rr[0]) + __uint_as_float(rr[1]); }

constexpr int DA_NB = 4, DA_KT = 16384, DA_VT = 128 * 144, DA_K0 = 0, DA_V0 = DA_NB * DA_KT, DA_SCR = DA_V0 + DA_NB * DA_VT, DA_XCH = 0;
static_assert(DA_SCR + 8 * 256 <= PHASE_LDS && DA_XCH + 4 * 16384 <= DA_SCR, "diff-attn LDS");
constexpr float DA_THR = 11.5f;
__device__ __forceinline__ void da_partialSM(f32x16& p0, f32x16& p1, float& m_reg, float& alpha) {
    float pmax = p0[0];
#pragma unroll
    for (int r = 1; r < 16; ++r) pmax = fmaxf(pmax, p0[r]);
#pragma unroll
    for (int r = 0; r < 16; ++r) pmax = fmaxf(pmax, p1[r]);
    pmax = half_max(pmax);
    float mn;
    if (__builtin_expect(__all(pmax - m_reg <= DA_THR), 1)) { mn = m_reg; alpha = 1.f; }
    else { mn = fmaxf(m_reg, pmax); alpha = __builtin_amdgcn_exp2f(m_reg - mn); m_reg = mn; }
#pragma unroll
    for (int r = 0; r < 16; ++r) { p0[r] -= mn; p1[r] -= mn; }
#pragma unroll
    for (int r = 0; r < 16; ++r) p0[r] = __builtin_amdgcn_exp2f(p0[r]);
#if DA_BAL
#pragma unroll
    for (int r = 0; r < 16; ++r) p1[r] = __builtin_amdgcn_exp2f(p1[r]);
#endif
}
__device__ __forceinline__ void da_finishSM(f32x16& p0, f32x16& p1, const float alpha, float& l_reg, bf16x8& pa0, bf16x8& pa1, bf16x8& pa2, bf16x8& pa3) {
#if !DA_BAL
#pragma unroll
    for (int r = 0; r < 16; ++r) p1[r] = __builtin_amdgcn_exp2f(p1[r]);
#endif
    float ps = 0.f;
#pragma unroll
    for (int r = 0; r < 16; ++r) ps += p0[r];
#pragma unroll
    for (int r = 0; r < 16; ++r) ps += p1[r];
    ps = half_sum(ps);
    l_reg = l_reg * alpha + ps;
    PK4(p0, 0, pa0); PK4(p0, 8, pa1); PK4(p1, 0, pa2); PK4(p1, 8, pa3);
}
__device__ __forceinline__ void da_qkt(f32x16& p0, f32x16& p1, const LAS unsigned char* Ks, const bf16x8* qr, const int comp, const int r32, const int hi) {
#pragma unroll
    for (int r = 0; r < 16; ++r) { p0[r] = 0.f; p1[r] = 0.f; }
#pragma unroll
    for (int d0 = 0; d0 < 4; ++d0) { const int cb = (comp * 64 + d0 * 16 + hi * 8) * 2;
        const bf16x8 k0 = *(const LAS bf16x8*)(Ks + KSWZ(r32, cb)), k1 = *(const LAS bf16x8*)(Ks + KSWZ(32 + r32, cb));
        DA_PRIO(1);
        p0 = __builtin_amdgcn_mfma_f32_32x32x16_bf16(k0, qr[d0], p0, 0, 0, 0);
        p1 = __builtin_amdgcn_mfma_f32_32x32x16_bf16(k1, qr[d0], p1, 0, 0, 0);
        DA_PRIO(0); }
}
__device__ __forceinline__ void da_pv(f32x16* o, const LAS unsigned char* Vs, const bf16x8 pa0, const bf16x8 pa1, const bf16x8 pa2, const bf16x8 pa3, const int r32, const int hi) {
#pragma unroll
    for (int d0 = 0; d0 < 4; ++d0) { const LAS unsigned char* vp = Vs + (d0 * 32 + r32) * 144 + hi * 16;
        const bf16x8 v0 = *(const LAS bf16x8*)(vp), v1 = *(const LAS bf16x8*)(vp + 32), v2 = *(const LAS bf16x8*)(vp + 64), v3 = *(const LAS bf16x8*)(vp + 96);
        asm volatile("s_waitcnt lgkmcnt(0)" ::: "memory"); __builtin_amdgcn_sched_barrier(0);
        DA_PRIO(1);
        o[d0] = __builtin_amdgcn_mfma_f32_32x32x16_bf16(pa0, v0, o[d0], 0, 0, 0);
        o[d0] = __builtin_amdgcn_mfma_f32_32x32x16_bf16(pa1, v1, o[d0], 0, 0, 0);
        o[d0] = __builtin_amdgcn_mfma_f32_32x32x16_bf16(pa2, v2, o[d0], 0, 0, 0);
        o[d0] = __builtin_amdgcn_mfma_f32_32x32x16_bf16(pa3, v3, o[d0], 0, 0, 0);
        DA_PRIO(0); }
}
template <int VAR>
__device__ __forceinline__ void diff_attn_phase(LAS unsigned char* lds, const bf16_t* __restrict__ Q, const bf16_t* __restrict__ Kb, const bf16_t* __restrict__ VT, bf16_t* OAS,
                                                const float* subln_g, const float lam, const int G, const int c, const int wid) {
    const int lane = fresh_lane(), tid = wid * 64 + lane, r32 = lane & 31, hi = lane >> 5, comp = wid >> 2, w4 = wid & 3;
    LAS float* scr = (LAS float*)(lds + DA_SCR + wid * 256);
    constexpr int NT = SEQ / 64;
#define SBAR() __builtin_amdgcn_sched_barrier(0)
    for (int L = c; L < NBATCH * 4 * 16; L += G) {
        const int bh = L >> 4, qb = L & 15, b = bh >> 2, h = bh & 3;
        const size_t tok0 = (size_t)b * SEQ;
        bf16x8 qr[4];
        { const bf16_t* qp = Q + (tok0 + qb * 128 + w4 * 32 + r32) * 512 + h * 128 + comp * 64 + hi * 8;
#pragma unroll
          for (int d0 = 0; d0 < 4; ++d0) qr[d0] = *(const GAS bf16x8*)(qp + d0 * 16); }
        const bf16_t* kg = Kb + (tok0 + (tid >> 4)) * 512 + h * 128 + (tid & 15) * 8;
        const bf16_t* vg = VT + (size_t)(h * 128 + (tid >> 3)) * NTOK + tok0 + (tid & 7) * 8;
        const int kl0 = KSWZ((tid >> 4), (tid & 15) * 16), kl1 = KSWZ(32 + (tid >> 4), (tid & 15) * 16), vl0 = (tid >> 3) * 144 + (tid & 7) * 16, vl1 = vl0 + 64 * 144;
        bf16x8 ek0, ek1, ev0, ev1, fk0, fk1, fv0, fv1;
#define DA_LOAD(k0_, k1_, v0_, v1_, j) do { k0_ = *(const GAS bf16x8*)(kg + (size_t)(j) * 64 * 512); k1_ = *(const GAS bf16x8*)(kg + (size_t)((j) * 64 + 32) * 512); \
                        v0_ = *(const GAS bf16x8*)(vg + (j) * 64); v1_ = *(const GAS bf16x8*)(vg + (size_t)64 * NTOK + (j) * 64); } while (0)
#define DA_WRITE(bf, k0_, k1_, v0_, v1_) do { *(LAS bf16x8*)(lds + DA_K0 + (bf) * DA_KT + kl0) = k0_; *(LAS bf16x8*)(lds + DA_K0 + (bf) * DA_KT + kl1) = k1_; \
                          *(LAS bf16x8*)(lds + DA_V0 + (bf) * DA_VT + vl0) = v0_; *(LAS bf16x8*)(lds + DA_V0 + (bf) * DA_VT + vl1) = v1_; } while (0)
#define DA_SWAIT() asm volatile("s_waitcnt vmcnt(4)" ::: "memory")
#define DA_SYNC() do { if (VAR != 3) __syncthreads(); } while (0)
#define DA_RESC(a) do { if (__any((a) < 1.f)) { if (hi == 0) scr[r32] = (a); LDS_WAIT(); \
            _Pragma("unroll") for (int r = 0; r < 16; ++r) { const float a_ = scr[crow(r, hi)]; _Pragma("unroll") for (int d = 0; d < 4; ++d) o[d][r] *= a_; } } } while (0)
        float m_reg = -1e30f, l_reg = 0.f, al; f32x16 o[4], p0, p1; bf16x8 pa0, pa1, pa2, pa3;
#pragma unroll
        for (int d = 0; d < 4; ++d)
#pragma unroll
            for (int r = 0; r < 16; ++r) o[d][r] = 0.f;
#define DA_BAR() do { asm volatile("s_waitcnt lgkmcnt(0)" ::: "memory"); __builtin_amdgcn_s_barrier(); } while (0)
#define DA_KB(b) (lds + DA_K0 + (b) * DA_KT)
#define DA_VB(b) (lds + DA_V0 + (b) * DA_VT)
        DA_LOAD(ek0, ek1, ev0, ev1, 0); VM_WAIT(); DA_WRITE(0, ek0, ek1, ev0, ev1);
        DA_LOAD(ek0, ek1, ev0, ev1, 1); VM_WAIT(); DA_WRITE(1, ek0, ek1, ev0, ev1);
        DA_LOAD(ek0, ek1, ev0, ev1, 2);
        DA_BAR();
        if (comp == 1) DA_BAR();
#pragma unroll 1
        for (int t = 0; t < NT; t += 4) {
#pragma unroll
            for (int k = 0; k < 4; ++k) { const int u = t + k;
                SBAR(); da_qkt(p0, p1, DA_KB(k), qr, comp, r32, hi); da_partialSM(p0, p1, m_reg, al); SBAR();
                DA_BAR();
                da_finishSM(p0, p1, al, l_reg, pa0, pa1, pa2, pa3); DA_RESC(al); SBAR();
                if (u + 2 < NT) { VM_WAIT(); DA_WRITE((k + 2) & 3, ek0, ek1, ev0, ev1); }
                if (u + 3 < NT) DA_LOAD(ek0, ek1, ev0, ev1, u + 3);
                SBAR(); da_pv(o, DA_VB(k), pa0, pa1, pa2, pa3, r32, hi); SBAR();
                DA_BAR();
            }
        }
        if (comp == 0) DA_BAR();
#undef DA_BAR
#undef DA_KB
#undef DA_VB
        __syncthreads();
        if (hi == 0) scr[r32] = __builtin_amdgcn_rcpf(l_reg);
        LDS_WAIT();
#pragma unroll
        for (int r = 0; r < 16; ++r) { const float a = scr[crow(r, hi)];
#pragma unroll
            for (int d = 0; d < 4; ++d) o[d][r] *= a; }
        LAS float* xch = (LAS float*)(lds + DA_XCH + w4 * 16384);
        if (comp == 1) {
#pragma unroll
            for (int d = 0; d < 4; ++d)
#pragma unroll
                for (int r = 0; r < 16; ++r) xch[(d * 16 + r) * 64 + lane] = o[d][r];
        }
        __syncthreads();
        if (comp == 0) {
            float ssq[16];
#pragma unroll
            for (int r = 0; r < 16; ++r) ssq[r] = 0.f;
#pragma unroll
            for (int d = 0; d < 4; ++d)
#pragma unroll
                for (int r = 0; r < 16; ++r) { const float v = o[d][r] - lam * xch[(d * 16 + r) * 64 + lane]; o[d][r] = v; ssq[r] += v * v; }
#pragma unroll
            for (int r = 0; r < 16; ++r) {
                float s = ssq[r];
                s += __shfl_xor(s, 1); s += __shfl_xor(s, 2); s += __shfl_xor(s, 4); s += __shfl_xor(s, 8); s += __shfl_xor(s, 16);
                ssq[r] = __builtin_amdgcn_rsqf(s * (1.0f / 128.0f) + EPS) * (1.0f - LAMBDA_INIT);
            }
            const int lnb = fresh_lane(), r32b = lnb & 31, hib = lnb >> 5;
            bf16_t* op = OAS + (tok0 + qb * 128 + w4 * 32) * 1024 + h * 128 + r32b;
#pragma unroll
            for (int d = 0; d < 4; ++d) { const float g = subln_g[d * 32 + r32b];
#pragma unroll
                for (int r = 0; r < 16; ++r) { const float v = o[d][r] * ssq[r] * g; op[(size_t)crow(r, hib) * 1024 + d * 32] = (bf16_t)(cvt_pk_bf16(v, 0.f) & 0xffffu); } }
        }
        __syncthreads();
#undef DA_LOAD
#undef DA_WRITE
#undef DA_SWAIT
#undef DA_SYNC
#undef DA_RESC
    }
#undef SBAR
}

#define XSWZ(row, chunk) ((row) * 528 + (chunk) * 16)
constexpr int XA_BYTES = 256 * 528;
__device__ __forceinline__ void cross_attn_unit(LAS unsigned char* lds, const bf16_t* __restrict__ XQ, const bf16_t* __restrict__ XK, const bf16_t* __restrict__ XVT, unsigned char* XO, const int b, const int h, const int qb, const int wid) {
    const int lane = fresh_lane(), tid = wid * 64 + lane, r32 = lane & 31, hi = lane >> 5;
    LAS float* scr = (LAS float*)(lds + XA_BYTES + wid * 256);
    {
        { const bf16_t* src = XK + ((size_t)b * NMEM + (tid >> 5)) * 1024 + h * 256 + (tid & 31) * 8; LAS unsigned char* dst = lds + XSWZ(tid >> 5, tid & 31);
#pragma unroll 1
          for (int i0 = 0; i0 < 16; i0 += 8) { bf16x8 t[8];
#pragma unroll
            for (int i = 0; i < 8; ++i) t[i] = *(const bf16x8*)(src + (size_t)(i0 + i) * 16 * 1024);
#pragma unroll
            for (int i = 0; i < 8; ++i) *(LAS bf16x8*)(dst + (i0 + i) * 16 * 528) = t[i]; } }
        const bf16_t* qp = XQ + ((size_t)b * SEQ + qb * 256 + wid * 32 + r32) * 1024 + h * 256 + hi * 8;
        bf16x8 pa[16]; float linv;
        {
            f32x16 s[8];
#pragma unroll
            for (int kb = 0; kb < 8; ++kb)
#pragma unroll
                for (int r = 0; r < 16; ++r) s[kb][r] = 0.f;
            bf16x8 qa[2], qn[2];
#pragma unroll
            for (int i = 0; i < 2; ++i) qa[i] = *(const bf16x8*)(qp + i * 16);
            __syncthreads();
#pragma unroll
            for (int dg = 0; dg < 8; ++dg) {
                if (dg < 7) {
#pragma unroll
                    for (int i = 0; i < 2; ++i) qn[i] = *(const bf16x8*)(qp + (dg * 2 + 2 + i) * 16);
                }
                __builtin_amdgcn_sched_barrier(0);
#pragma unroll
                for (int i = 0; i < 2; ++i) { const int d0 = dg * 2 + i;
#pragma unroll
                    for (int kb = 0; kb < 8; ++kb) { const bf16x8 kf = *(const LAS bf16x8*)(lds + XSWZ(kb * 32 + r32, d0 * 2 + hi));
                        s[kb] = __builtin_amdgcn_mfma_f32_32x32x16_bf16(kf, qa[i], s[kb], 0, 0, 0); } }
                __builtin_amdgcn_sched_barrier(0);
#pragma unroll
                for (int i = 0; i < 2; ++i) qa[i] = qn[i];
            }
            float mx = s[0][0];
#pragma unroll
            for (int kb = 0; kb < 8; ++kb)
#pragma unroll
                for (int r = 0; r < 16; ++r) mx = fmaxf(mx, s[kb][r]);
            mx = half_max(mx);
            float ps = 0.f;
#pragma unroll
            for (int kb = 0; kb < 8; ++kb)
#pragma unroll
                for (int r = 0; r < 16; ++r) { s[kb][r] = __builtin_amdgcn_exp2f(s[kb][r] - mx); ps += s[kb][r]; }
            ps = half_sum(ps); linv = __builtin_amdgcn_rcpf(ps);
#pragma unroll
            for (int kb = 0; kb < 8; ++kb) { PK4(s[kb], 0, pa[2 * kb]); PK4(s[kb], 8, pa[2 * kb + 1]); }
        }
        __syncthreads();
        { const bf16_t* src = XVT + ((size_t)h * 256 + (tid >> 5)) * NMEMTOK + b * NMEM + (tid & 31) * 8; LAS unsigned char* dst = lds + XSWZ(tid >> 5, tid & 31);
#pragma unroll 1
          for (int i0 = 0; i0 < 16; i0 += 8) { bf16x8 t[8];
#pragma unroll
            for (int i = 0; i < 8; ++i) t[i] = *(const bf16x8*)(src + (size_t)(i0 + i) * 16 * NMEMTOK);
#pragma unroll
            for (int i = 0; i < 8; ++i) *(LAS bf16x8*)(dst + (i0 + i) * 16 * 528) = t[i]; } }
        if (hi == 0) scr[r32] = linv * XOSCALE;
        __syncthreads();
        unsigned char* op = XO + ((size_t)b * SEQ + qb * 256 + wid * 32) * 1024 + h * 256 + r32;
#pragma unroll
        for (int cb = 0; cb < 8; ++cb) {
            f32x16 o;
#pragma unroll
            for (int r = 0; r < 16; ++r) o[r] = 0.f;
#pragma unroll
            for (int ks = 0; ks < 16; ++ks) { const bf16x8 vf = *(const LAS bf16x8*)(lds + XSWZ(cb * 32 + r32, ks * 2 + hi));
                o = __builtin_amdgcn_mfma_f32_32x32x16_bf16(pa[ks], vf, o, 0, 0, 0); }
#pragma unroll
            for (int r = 0; r < 16; ++r) { const float v = o[r] * scr[crow(r, hi)]; op[(size_t)crow(r, hi) * 1024 + cb * 32] = (unsigned char)__builtin_amdgcn_cvt_pk_fp8_f32(v, 0.f, 0, false); }
        }
        __syncthreads();
    }
}
constexpr int TP_PITCH = 136;
template <bool HAS_GAIN, class RowMap>
__device__ __forceinline__ void transpose_item(const float* __restrict__ W, const int K, const int N, bf16_t* WT, const float* gain, const RowMap& drow, LAS unsigned char* scr, const int item, const int lane, const int pitch = 0) {
    const int nblk = N / 64, kb = item / nblk, nb = item % nblk, k0 = kb * 64, n0 = nb * 64;
    const int nl = (lane & 15) * 4, kq = lane >> 4;
#pragma unroll
    for (int p = 0; p < 8; ++p) { const int kk = p * 8 + kq * 2;
        f32x4 a = *(const f32x4*)(W + (size_t)(k0 + kk) * N + n0 + nl), b = *(const f32x4*)(W + (size_t)(k0 + kk + 1) * N + n0 + nl);
        if (HAS_GAIN) { const float g0 = gain[k0 + kk], g1 = gain[k0 + kk + 1]; a = a * g0; b = b * g1; }
#pragma unroll
        for (int j = 0; j < 4; ++j) *(LAS unsigned*)(scr + (nl + j) * TP_PITCH + kk * 2) = cvt_pk_bf16(a[j], b[j]); }
    LDS_WAIT();
#pragma unroll
    for (int q = 0; q < 8; ++q) { const int n = q * 8 + (lane >> 3), ch = lane & 7;
        const u32x2 lo = *(const LAS u32x2*)(scr + n * TP_PITCH + ch * 16), hi = *(const LAS u32x2*)(scr + n * TP_PITCH + ch * 16 + 8);
        const int dr = drow(n0 + (n & ~7)) + (n & 7);
        *(u32x4*)(WT + (size_t)dr * (pitch ? pitch : K) + k0 + ch * 8) = (u32x4){lo.x, lo.y, hi.x, hi.y}; }
    LDS_WAIT();
}
template <class RowMap>
__device__ __forceinline__ void transpose_item_f8(const float* __restrict__ W, const int K, const int N, unsigned char* WT, const float* gain, const float scale, const RowMap& drow, LAS unsigned char* scr, const int item, const int lane) {
    const int nblk = N / 64, kb = item / nblk, nb = item % nblk, k0 = kb * 64, n0 = nb * 64;
    const int nl = (lane & 15) * 4, kq = lane >> 4;
#pragma unroll
    for (int p = 0; p < 4; ++p) { const int kk = p * 16 + kq * 4; f32x4 a[4];
#pragma unroll
        for (int r = 0; r < 4; ++r) { a[r] = *(const f32x4*)(W + (size_t)(k0 + kk + r) * N + n0 + nl); a[r] = a[r] * ((gain ? gain[k0 + kk + r] : 1.0f) * scale); }
#pragma unroll
        for (int j = 0; j < 4; ++j) *(LAS unsigned*)(scr + (nl + j) * 80 + kk) = pack4_fp8(a[0][j], a[1][j], a[2][j], a[3][j]); }
    LDS_WAIT();
#pragma unroll
    for (int q = 0; q < 4; ++q) { const int n = q * 16 + (lane >> 2), ch = lane & 3;
        const u32x4 v = *(const LAS u32x4*)(scr + n * 80 + ch * 16);
        const int dr = drow(n0 + (n & ~7)) + (n & 7);
        *(u32x4*)(WT + (size_t)dr * K + k0 + ch * 16) = v; }
    LDS_WAIT();
}
struct ExpItem { const float* W; unsigned char* WT; const float* gain; int K, N, k0, n0, doff, is_e1; };
__device__ __forceinline__ ExpItem exp_item(const int it, const float* we1, const float* we2, const float* gffn, unsigned char* ws) {
    ExpItem x;
    if (it < 32 * 512) { const int e = it >> 9, r = it & 511; x.W = we1 + (size_t)e * 1024 * 2048; x.WT = ws + WS_WE1; x.gain = gffn; x.K = 1024; x.N = 2048; x.k0 = (r >> 6) * 128; x.n0 = (r & 63) * 32; x.doff = e * 2048; x.is_e1 = 1; }
    else { const int q = it - 32 * 512, e = q >> 8, r = q & 255; x.W = we2 + (size_t)e * 1024 * 1024; x.WT = ws + WS_WE2; x.gain = nullptr; x.K = 1024; x.N = 1024; x.k0 = (r >> 5) * 128; x.n0 = (r & 31) * 32; x.doff = e * 1024; x.is_e1 = 0; }
    return x;
}
__device__ __forceinline__ void exp_load(const ExpItem& x, f32x4 (&a)[4][4], const int lane) {
    const unsigned lane_off = (unsigned)(((lane >> 3) * 4 * x.N + (lane & 7) * 4) * 4);
#pragma unroll
    for (int p = 0; p < 4; ++p)
#pragma unroll
        for (int r = 0; r < 4; ++r) { const char* rowp = (const char*)(x.W + (size_t)(x.k0 + p * 32 + r) * x.N + x.n0); a[p][r] = *(const f32x4*)(rowp + lane_off); }
}
template <bool E1>
__device__ __forceinline__ void exp_store(const ExpItem& x, f32x4 (&a)[4][4], LAS unsigned char* scr, const int lane) {
    const int nl = (lane & 7) * 4, kq = lane >> 3;
#pragma unroll
    for (int p = 0; p < 4; ++p) { const int kk = p * 32 + kq * 4;
#pragma unroll
        for (int r = 0; r < 4; ++r) a[p][r] = a[p][r] * ((E1 ? x.gain[x.k0 + kk + r] : 1.0f) * W8SCALE);
#pragma unroll
        for (int j = 0; j < 4; ++j) *(LAS unsigned*)(scr + (nl + j) * 144 + kk) = pack4_fp8(a[p][0][j], a[p][1][j], a[p][2][j], a[p][3][j]); }
    LDS_WAIT();
#pragma unroll
    for (int q = 0; q < 4; ++q) { const int n = q * 8 + (lane >> 3), ch = lane & 7;
        const u32x4 v = *(const LAS u32x4*)(scr + n * 144 + ch * 16);
        const int ns = x.n0 + n; int dr;
        if (E1) { const int bj = ns >> 10, rr = ns & 1023; dr = x.doff + (rr >> 7) * 256 + bj * 128 + (rr & 127); } else dr = x.doff + ns;
        *(u32x4*)(x.WT + (size_t)dr * x.K + x.k0 + ch * 16) = v; }
    LDS_WAIT();
}
__device__ __forceinline__ int opaque_s(int v) { asm volatile("" : "+s"(v)); return v; }
template <bool E1>
__device__ __forceinline__ void expert_convert(const float* we1, const float* we2, const float* gffn, unsigned char* ws, LAS unsigned char* scr, const int lo, const int hi, const int gw, const int NGW, const int lane) {
    f32x4 A[4][4], B[4][4];
    int it = lo + gw;
    if (it < hi) exp_load(exp_item(opaque_s(it), we1, we2, gffn, ws), A, lane);
    for (; it < hi; it += 2 * NGW) { const int it1 = it + NGW, it2 = it1 + NGW;
        if (it1 < hi) exp_load(exp_item(opaque_s(it1), we1, we2, gffn, ws), B, lane);
        exp_store<E1>(exp_item(opaque_s(it), we1, we2, gffn, ws), A, scr, lane);
        if (it1 < hi) { if (it2 < hi) exp_load(exp_item(opaque_s(it2), we1, we2, gffn, ws), A, lane);
            exp_store<E1>(exp_item(opaque_s(it1), we1, we2, gffn, ws), B, scr, lane); } }
}
struct MapIdent { int off; __device__ __forceinline__ int operator()(int n) const { return off + n; } };
struct MapWin {
    __device__ __forceinline__ int operator()(int n) const {
        if (n < 1024) { const int blk = n >> 9, r = n & 511, tile = r >> 8, w = (r & 255) >> 6, half = (r & 63) >> 5, i = r & 31; return blk * 512 + tile * 256 + w * 64 + (i >> 3) * 16 + half * 8; }
        if (n < 1536) return 3584 + (n - 1024);
        return n - 512;
    }
};
struct MapGatePair {
    __device__ __forceinline__ int operator()(int n) const { const int isgs = n >= 3072 ? 1 : 0, g = (n - 2048) & 1023, t = g >> 7, w = g & 127; return 512 + t * 256 + (w >> 5) * 64 + ((w >> 3) & 3) * 16 + isgs * 8; }
};
struct MapGlu { __device__ __forceinline__ int operator()(int n) const { const int bj = n >> 9, r = n & 511; return (r >> 7) * 256 + bj * 128 + (r & 127); } };
struct MapE1 { int off; __device__ __forceinline__ int operator()(int n) const { const int bj = n >> 10, r = n & 1023; return off + (r >> 7) * 256 + bj * 128 + (r & 127); } };

struct Params {
    const float* in[34]; float* out; unsigned char* ws; int ph_lo, ph_hi;
};
enum { I_X = 0, I_MEM, I_NMIXG, I_WIN, I_LQ1, I_LK1, I_LQ2, I_LK2, I_SUBLN, I_ARE, I_AIM, I_LOGDT, I_BRE, I_BIM, I_CRE, I_CIM, I_SSMD, I_WGLU, I_WBA, I_WBS, I_WMIX, I_NCROSSG, I_NMEMG,
       I_WXQ, I_WXKV, I_WXO, I_NFFNG, I_WROUTER, I_BROUTER, I_WE1, I_BE1, I_WE2, I_BE2, I_NFING };

typedef const Params __attribute__((address_space(4)))* KParams;
__device__ __forceinline__ void prologue_phase(LAS unsigned char* lds, KParams Pk, unsigned char* ws, const int G, const int c, const int wid) {
    const int lane = fresh_lane(), tid = wid * 64 + lane;
    const int gw = c * 8 + wid, NGW = G * 8;
    LAS unsigned char* scr = lds + wid * 16384;
    constexpr int IT_WIN = 16 * 64, IT_GLU = 8 * 16, IT_BA = 8 * 16, IT_MIX = 16 * 16, IT_XQ = 256, IT_XKV = 16 * 32, IT_XO = 256, IT_E1 = 16 * 32, IT_E2 = 16 * 16;
    constexpr int NIT = IT_WIN + IT_GLU + 2 * IT_BA + IT_MIX + IT_XQ + IT_XKV + IT_XO;
    for (int it = gw; it < NIT; it += NGW) {
        int r = it;
        if (r < IT_WIN) { if ((r & 63) < 32) transpose_item<true>(Pk->in[I_WIN], 1024, 4096, (bf16_t*)(ws + WS_WIN), Pk->in[I_NMIXG], MapWin{}, scr, r, lane);
            else transpose_item_f8(Pk->in[I_WIN], 1024, 4096, ws + WS_WIN8, Pk->in[I_NMIXG], W8SCALE, MapGatePair{}, scr, r, lane); continue; } r -= IT_WIN;
        if (r < IT_GLU) { transpose_item_f8(Pk->in[I_WGLU], 512, 1024, ws + WS_WGLU, nullptr, W8SCALE, MapGlu{}, scr, r, lane); continue; } r -= IT_GLU;
        if (r < IT_BA) { transpose_item<false>(Pk->in[I_WBA], 512, 1024, (bf16_t*)(ws + WS_WBA), nullptr, MapIdent{0}, scr, r, lane, 1024); continue; } r -= IT_BA;
        if (r < IT_BA) { transpose_item<false>(Pk->in[I_WBS], 512, 1024, (bf16_t*)(ws + WS_WBA) + 512, nullptr, MapIdent{0}, scr, r, lane, 1024); continue; } r -= IT_BA;
        if (r < IT_MIX) { transpose_item<false>(Pk->in[I_WMIX], 1024, 1024, (bf16_t*)(ws + WS_WMIX), nullptr, MapIdent{0}, scr, r, lane); continue; } r -= IT_MIX;
        if (r < IT_XQ) { transpose_item_f8(Pk->in[I_WXQ], 1024, 1024, ws + WS_WXQ8, Pk->in[I_NCROSSG], W8SCALE, MapIdent{0}, scr, r, lane); continue; } r -= IT_XQ;
        if (r < IT_XKV) { transpose_item_f8(Pk->in[I_WXKV], 1024, 2048, ws + WS_WXK, nullptr, W8SCALE, MapIdent{0}, scr, r, lane); continue; } r -= IT_XKV;
        transpose_item_f8(Pk->in[I_WXO], 1024, 1024, ws + WS_WXO, nullptr, W8SCALE, MapIdent{0}, scr, r, lane);
    }
    { bf16_t* XB = (bf16_t*)(ws + WS_XB); unsigned char* XB8 = ws + WS_XB8; float* rstd0 = (float*)(ws + WS_RSTD0); const float* x = Pk->in[I_X];
      for (int m = gw; m < NTOK; m += NGW) { f32x4 v[4]; float s = 0.f;
#pragma unroll
          for (int q = 0; q < 4; ++q) { v[q] = *(const f32x4*)(x + (size_t)m * 1024 + q * 256 + lane * 4); s += (v[q][0] * v[q][0] + v[q][1] * v[q][1]) + (v[q][2] * v[q][2] + v[q][3] * v[q][3]); }
          s = wave_sum(s);
#pragma unroll
          for (int q = 0; q < 4; ++q) { *(u32x2*)(XB + (size_t)m * 1024 + q * 256 + lane * 4) = (u32x2){cvt_pk_bf16(v[q][0], v[q][1]), cvt_pk_bf16(v[q][2], v[q][3])};
              *(unsigned*)(XB8 + (size_t)m * 1024 + q * 256 + lane * 4) = pack4_fp8(v[q][0], v[q][1], v[q][2], v[q][3]); }
          if (lane == 0) rstd0[m] = __builtin_amdgcn_rsqf(s * (1.0f / DM) + EPS); } }
    { unsigned char* MN = ws + WS_MEMN; const float* mem = Pk->in[I_MEM]; const float* gm = Pk->in[I_NMEMG];
      for (int m = gw; m < NMEMTOK; m += NGW) { f32x4 v[4]; float s = 0.f;
#pragma unroll
          for (int q = 0; q < 4; ++q) { v[q] = *(const f32x4*)(mem + (size_t)m * 1024 + q * 256 + lane * 4); s += (v[q][0] * v[q][0] + v[q][1] * v[q][1]) + (v[q][2] * v[q][2] + v[q][3] * v[q][3]); }
          const float rs = __builtin_amdgcn_rsqf(wave_sum(s) * (1.0f / DM) + EPS);
#pragma unroll
          for (int q = 0; q < 4; ++q) { const f32x4 g = *(const f32x4*)(gm + q * 256 + lane * 4); const f32x4 o = v[q] * rs * g;
              *(unsigned*)(MN + (size_t)m * 1024 + q * 256 + lane * 4) = pack4_fp8(o[0], o[1], o[2], o[3]); } } }
    const int gt = c * 512 + tid, NGT = G * 512;
    { float* rope = (float*)(ws + WS_ROPE);
      for (int i = gt; i < SEQ * 32; i += NGT) { const int pos = i >> 5, f = i & 31; const float inv = exp2f(-(float)f * (13.287712379549449f / 32.0f)); float sn, cs; sincosf((float)pos * inv, &sn, &cs); rope[2 * i] = cs; rope[2 * i + 1] = sn; } }
    {
      float* AB = (float*)(ws + WS_S5AB); bf16_t* BB = (bf16_t*)(ws + WS_S5BB); bf16_t* CC = (bf16_t*)(ws + WS_S5CC);
      for (int i2 = gt; i2 < 2 * 32 * 64 * 16; i2 += NGT) { const int h = i2 & 15, i = i2 >> 4, dg = i >> 6, p = i & 63;
          const float are = Pk->in[I_ARE][i], aim = Pk->in[I_AIM][i], dt = expf(Pk->in[I_LOGDT][dg]);
          const float mag = expf(are * dt), ang = aim * dt; float sn, cs; sincosf(ang, &sn, &cs);
          const float abr = mag * cs, abi = mag * sn, den = are * are + aim * aim, nr = abr - 1.0f;
          const float cre = (nr * are + abi * aim) / den, cim = (abi * are - nr * aim) / den;
          if (h == 0) { AB[2 * i] = abr; AB[2 * i + 1] = abi; }
          const float br = Pk->in[I_BRE][(size_t)i * 16 + h], bi = Pk->in[I_BIM][(size_t)i * 16 + h];
          BB[((size_t)dg * 128 + 2 * p) * 16 + h] = (bf16_t)(cvt_pk_bf16(cre * br - cim * bi, 0.f) & 0xffffu);
          BB[((size_t)dg * 128 + 2 * p + 1) * 16 + h] = (bf16_t)(cvt_pk_bf16(cre * bi + cim * br, 0.f) & 0xffffu);
          const float crv = Pk->in[I_CRE][(size_t)dg * 16 * 64 + h * 64 + p], civ = Pk->in[I_CIM][(size_t)dg * 16 * 64 + h * 64 + p];
          CC[((size_t)dg * 16 + h) * 128 + 2 * p] = (bf16_t)(cvt_pk_bf16(crv, 0.f) & 0xffffu);
          CC[((size_t)dg * 16 + h) * 128 + 2 * p + 1] = (bf16_t)(cvt_pk_bf16(-civ, 0.f) & 0xffffu); } }
    {
      bf16_t* WR = (bf16_t*)(ws + WS_WR); const float* wrt = Pk->in[I_WROUTER]; const float* gf = Pk->in[I_NFFNG];
      for (int i = gt; i < 32 * 1024; i += NGT) { const int e = i >> 10, k = i & 1023; const float v = wrt[k * 32 + e] * gf[k]; const unsigned hb = cvt_pk_bf16(v, 0.f) & 0xffffu; const float lo = v - bf_lo(hb);
          const int pos = ((((k >> 5) * 4 + (e >> 4)) * 64 + ((k >> 3) & 3) * 16 + (e & 15)) << 3) + (k & 7);
          WR[pos] = (bf16_t)hb; WR[pos + 2 * 64 * 8] = (bf16_t)(cvt_pk_bf16(lo, 0.f) & 0xffffu); } }
    if (c == G - 1 && wid == 7) { const float s1 = wave_sum(Pk->in[I_LQ1][lane] * Pk->in[I_LK1][lane]), s2 = wave_sum(Pk->in[I_LQ2][lane] * Pk->in[I_LK2][lane]);
        if (lane == 0) *(float*)(ws + WS_LAM) = expf(s1) - expf(s2) + LAMBDA_INIT; }
}
constexpr int S5_T = 32, S5_NC = SEQ / S5_T, S5_BP = 132  , S5_BU = S5_T * S5_BP * 4, S5_XP = 272, S5_X = S5_T * S5_XP, S5_WAVE = S5_BU + S5_X;
static_assert(4 * S5_WAVE + 4 * 8192 <= PHASE_LDS, "S5 LDS");
__device__ __forceinline__ float gelu_tanh(float x) { const float z = 0.7978845608028654f * (x + 0.044715f * x * x * x); return x * __builtin_amdgcn_rcpf(1.0f + __builtin_amdgcn_exp2f(-2.0f * LOG2E * z)); }
template <int DIR>
__device__ __forceinline__ void s5_scan_wave(LAS unsigned char* lds, const bf16_t* U, float* YP, unsigned char* SG, const float* s5ab, const bf16_t* s5bb, const bf16_t* s5cc, const float* dskip, const int pair, const int wid, const int lane) {
    const int fr = lane & 15, fq = lane >> 4;
        const int dir = DIR, b = pair >> 5, g = pair & 31;
        LAS float* BU = (LAS float*)(lds + (wid & 3) * S5_WAVE); LAS unsigned char* XS = lds + (wid & 3) * S5_WAVE + S5_BU;
        bf16x8 bb[8], cc[4]; float ar, ai, nai, xr = 0.f, xi = 0.f, dsk;
        { const bf16_t* bp = s5bb + (size_t)(dir * 32 + g) * 128 * 16;
#pragma unroll
          for (int cb = 0; cb < 8; ++cb) { if (fq < 2) bb[cb] = *(const bf16x8*)(bp + (cb * 16 + fr) * 16 + fq * 8); else bb[cb] = (bf16x8){0, 0, 0, 0, 0, 0, 0, 0}; }
          const bf16_t* cp = s5cc + (size_t)(dir * 32 + g) * 16 * 128;
#pragma unroll
          for (int kb = 0; kb < 4; ++kb) cc[kb] = *(const bf16x8*)(cp + fr * 128 + kb * 32 + fq * 8);
          const float* ap = s5ab + ((size_t)(dir * 32 + g) * 64 + lane) * 2; ar = ap[0]; ai = ap[1]; nai = -ai;
          dsk = dskip[g * 16 + fr]; }
        const bf16x8 zero8 = (bf16x8){0, 0, 0, 0, 0, 0, 0, 0};
#define S5_TC(ci_) (dir ? (S5_NC - 1 - (ci_)) : (ci_))
#define S5_LOADU(ci_, A0, A1) do { const int l_ = fresh_lane(), fr = l_ & 15, fq = l_ >> 4; const size_t tk_ = (size_t)b * SEQ + S5_TC(ci_) * S5_T; const bf16_t* p0_ = U + (tk_ + fr) * 512 + g * 16 + (fq & 1) * 8; const bf16_t* p1_ = p0_ + 16 * 512; \
            asm volatile("global_load_dwordx4 %0, %1, off" : "=v"(A0) : "v"(p0_) : "memory"); asm volatile("global_load_dwordx4 %0, %1, off" : "=v"(A1) : "v"(p1_) : "memory"); } while (0)
#define S5_LOADPU(ci_) do { const int l_ = fresh_lane(), fr = l_ & 15, fq = l_ >> 4; const size_t tk_ = (size_t)b * SEQ + S5_TC(ci_) * S5_T; _Pragma("unroll") for (int q_ = 0; q_ < 8; ++q_) { const size_t off_ = (tk_ + (q_ >> 2) * 16 + fq * 4 + (q_ & 3)) * 512 + g * 16 + fr; const float* yp_ = YP + off_; const bf16_t* up_ = U + off_; \
            asm volatile("global_load_dword %0, %1, off sc1" : "=v"(pt[q_]) : "v"(yp_) : "memory"); asm volatile("global_load_ushort %0, %1, off" : "=v"(uv[q_]) : "v"(up_) : "memory"); } } while (0)
#define S5_TIE_U(A0, A1) asm volatile("" : "+v"(A0), "+v"(A1) :: "memory")
#define S5_TIE_PU() asm volatile("" : "+v"(pt[0]), "+v"(pt[1]), "+v"(pt[2]), "+v"(pt[3]), "+v"(pt[4]), "+v"(pt[5]), "+v"(pt[6]), "+v"(pt[7]), "+v"(uv[0]), "+v"(uv[1]), "+v"(uv[2]), "+v"(uv[3]), "+v"(uv[4]), "+v"(uv[5]), "+v"(uv[6]), "+v"(uv[7]) :: "memory")
#define S5_BUM(i, A0, A1) do { const bf16x8 ua_ = ((i) >> 3) ? A1 : A0; const f32x4 d_ = __builtin_amdgcn_mfma_f32_16x16x32_bf16(fq < 2 ? ua_ : zero8, bb[(i) & 7], (f32x4){0.f, 0.f, 0.f, 0.f}, 0, 0, 0); \
            _Pragma("unroll") for (int j_ = 0; j_ < 4; ++j_) BU[(((i) >> 3) * 16 + fq * 4 + j_) * S5_BP + ((i) & 7) * 16 + fr] = d_[j_]; } while (0)
#define S5_OUT(H, ci_) do { const int l_ = fresh_lane(), fr = l_ & 15, fq = l_ >> 4; const size_t tk_ = (size_t)b * SEQ + S5_TC(ci_) * S5_T; _Pragma("unroll") for (int rb_ = 0; rb_ < 2; ++rb_) { \
            if (H == 0) { float* d_ = YP + (tk_ + rb_ * 16 + fq * 4 + 2) * 512 + g * 16 + fr; \
                asm volatile("s_nop 7\n\ts_nop 7\n\ts_nop 4\n\tglobal_store_dword %0, %1, off offset:-4096\n\tglobal_store_dword %0, %2, off offset:-2048\n\tglobal_store_dword %0, %3, off\n\tglobal_store_dword %0, %4, off offset:2048" \
                             :: "v"(d_), "v"(yv[rb_][0]), "v"(yv[rb_][1]), "v"(yv[rb_][2]), "v"(yv[rb_][3]) : "memory"); } \
            else { unsigned char* d_ = SG + (tk_ + rb_ * 16 + fq * 4) * 512 + g * 16 + fr; \
                asm volatile("global_store_byte %0, %1, off\n\tglobal_store_byte %0, %2, off offset:512\n\tglobal_store_byte %0, %3, off offset:1024\n\tglobal_store_byte %0, %4, off offset:1536" \
                             :: "v"(d_), "v"(pk[rb_ * 4 + 0]), "v"(pk[rb_ * 4 + 1]), "v"(pk[rb_ * 4 + 2]), "v"(pk[rb_ * 4 + 3]) : "memory"); } } } while (0)
#define S5_ITER(H) do { \
              \
            pa0 = qa0; pa1 = qa1; \
            if (H == 1) { _Pragma("unroll") for (int q = 0; q < 8; ++q) z[q] = pt[q] + dsk * bf_lo(uv[q]); } \
              \
            if (H == 1) S5_LOADPU(k); \
            if (k + 2 < ci1) S5_LOADU(k + 2, qa0, qa1); \
              \
            f32x2 bu[S5_T]; \
            _Pragma("unroll") for (int s = 0; s < S5_T; ++s) { const int t = DIR ? (S5_T - 1 - s) : s; bu[s] = *(const LAS f32x2*)(BU + t * S5_BP + 2 * lane); } \
            yv[0] = (f32x4){0.f, 0.f, 0.f, 0.f}; yv[1] = yv[0]; \
            { bf16x8 xa[2][4]; \
              _Pragma("unroll") for (int rb = 0; rb < 2; ++rb) _Pragma("unroll") for (int kb = 0; kb < 4; ++kb) xa[rb][kb] = *(const LAS bf16x8*)(XS + (rb * 16 + fr) * S5_XP + (kb * 32 + fq * 8) * 2); \
              LDS_WAIT(); \
              _Pragma("unroll") for (int q = 0; q < 8; ++q) yv[q >> 2] = __builtin_amdgcn_mfma_f32_16x16x32_bf16(xa[q >> 2][q & 3], cc[q & 3], yv[q >> 2], 0, 0, 0); } \
            __builtin_amdgcn_sched_barrier(0); \
              \
            unsigned pk[8]; _Pragma("unroll") for (int q = 0; q < 8; ++q) pk[q] = 0u; \
            _Pragma("unroll") for (int w = 0; w < 16; ++w) { \
                const bf16x8 ua_ = (w >> 3) ? pa1 : pa0; const f32x4 d_ = __builtin_amdgcn_mfma_f32_16x16x32_bf16(fq < 2 ? ua_ : zero8, bb[w & 7], (f32x4){0.f, 0.f, 0.f, 0.f}, 0, 0, 0); \
                _Pragma("unroll") for (int s2 = 0; s2 < 2; ++s2) { const int s = 2 * w + s2; const int t = DIR ? (S5_T - 1 - s) : s; float t1, t2; \
                    asm("v_fma_f32 %0, %1, %2, %3" : "=v"(t1) : "v"(nai), "v"(xi), "v"(bu[s].x)); \
                    asm("v_fma_f32 %0, %1, %2, %3" : "=v"(t2) : "v"(ai), "v"(xr), "v"(bu[s].y)); \
                    asm("v_fma_f32 %0, %1, %2, %3" : "=v"(xr) : "v"(ar), "v"(xr), "v"(t1)); \
                    asm("v_fma_f32 %0, %1, %2, %3" : "=v"(xi) : "v"(ar), "v"(xi), "v"(t2)); \
                    *(LAS unsigned*)(XS + t * S5_XP + lane * 4) = cvt_pk_bf16(xr, xi); } \
                if (H == 1 && (w & 1)) { const int q = w >> 1; pk[q] = fp8_1(gelu_tanh(yv[q >> 2][q & 3] + z[q]) * SGSCALE); } \
                _Pragma("unroll") for (int j_ = 0; j_ < 4; ++j_) BU[((w >> 3) * 16 + fq * 4 + j_) * S5_BP + (w & 7) * 16 + fr] = d_[j_]; \
                __builtin_amdgcn_sched_barrier(0); } \
              \
            if (k > ci0) S5_OUT(H, k - 1); \
              \
            if (k > ci0) asm volatile("s_waitcnt vmcnt(8)" ::: "memory"); else asm volatile("s_waitcnt vmcnt(0)" ::: "memory"); \
            S5_TIE_U(qa0, qa1); if (H == 1) S5_TIE_PU(); \
            LDS_WAIT(); } while (0)
#define S5_HALF(H) do { const int ci0 = (H) * (S5_NC / 2), ci1 = ((H) + 1) * (S5_NC / 2); \
            _Pragma("unroll") for (int q = 0; q < 8; ++q) { pt[q] = 0.f; uv[q] = 0u; z[q] = 0.f; } \
              \
            S5_LOADU(ci0, pa0, pa1); S5_LOADU(ci0 + 1, qa0, qa1); \
            asm volatile("s_waitcnt vmcnt(0)" ::: "memory"); S5_TIE_U(pa0, pa1); S5_TIE_U(qa0, qa1); \
            _Pragma("unroll") for (int i = 0; i < 16; ++i) S5_BUM(i, pa0, pa1); \
            LDS_WAIT(); \
            for (int k = ci0; k < ci1; ++k) S5_ITER(H); \
              \
            { bf16x8 xa[2][4]; unsigned pk[8]; \
              _Pragma("unroll") for (int rb = 0; rb < 2; ++rb) _Pragma("unroll") for (int kb = 0; kb < 4; ++kb) xa[rb][kb] = *(const LAS bf16x8*)(XS + (rb * 16 + fr) * S5_XP + (kb * 32 + fq * 8) * 2); \
              LDS_WAIT(); \
              yv[0] = (f32x4){0.f, 0.f, 0.f, 0.f}; yv[1] = yv[0]; \
              _Pragma("unroll") for (int q = 0; q < 8; ++q) yv[q >> 2] = __builtin_amdgcn_mfma_f32_16x16x32_bf16(xa[q >> 2][q & 3], cc[q & 3], yv[q >> 2], 0, 0, 0); \
              asm volatile("s_waitcnt vmcnt(0)" ::: "memory"); \
              _Pragma("unroll") for (int q = 0; q < 8; ++q) pk[q] = 0u; \
              if (H == 1) { S5_TIE_PU(); _Pragma("unroll") for (int q = 0; q < 8; ++q) pk[q] = fp8_1(gelu_tanh(yv[q >> 2][q & 3] + pt[q] + dsk * bf_lo(uv[q])) * SGSCALE); } \
              const int k = ci1; S5_OUT(H, k - 1); } \
            VM_WAIT(); \
            __syncthreads(); } while (0)
        { bf16x8 pa0, pa1, qa0 = zero8, qa1 = zero8; float pt[8], z[8]; unsigned uv[8]; f32x4 yv[2];
          S5_HALF(0);
          S5_HALF(1); }
#undef S5_ITER
#undef S5_HALF
#undef S5_TC
#undef S5_LOADU
#undef S5_LOADPU
#undef S5_TIE_U
#undef S5_TIE_PU
#undef S5_BUM
#undef S5_OUT
}
__device__ __forceinline__ void s5_phase(LAS unsigned char* lds, const bf16_t* U, float* YP, unsigned char* SG, const float* s5ab, const bf16_t* s5bb, const bf16_t* s5cc, const float* dskip, const float* we1, const float* we2, const float* gffn, unsigned char* ws, const int G, const int c, const int wid, const bool doconv = true, const bool doscan = true) {
    const int lane = fresh_lane(), tid = wid * 64 + lane, fr = lane & 15, fq = lane >> 4;
    for (int pp = c; pp < NBATCH * 32 / 2; pp += G) {
      if (wid < 4) {
        const int pair = pp * 2 + ((wid >> 1) & 1);
        if (!doscan) { __syncthreads(); __syncthreads(); }
        else if (wid & 1) s5_scan_wave<1>(lds, U, YP, SG, s5ab, s5bb, s5cc, dskip, pair, wid, lane); else s5_scan_wave<0>(lds, U, YP, SG, s5ab, s5bb, s5cc, dskip, pair, wid, lane);
      } else {
        LAS unsigned char* cscr = lds + 4 * S5_WAVE + (wid - 4) * 8192; const int gw4 = c * 4 + (wid - 4), n4 = G * 4;
        if (pp == c && doconv) expert_convert<true>(we1, we2, gffn, ws, cscr, 0, 12288, gw4, n4, lane);
        VM_WAIT(); __syncthreads();
        if (pp == c && doconv) { expert_convert<true>(we1, we2, gffn, ws, cscr, 12288, 16384, gw4, n4, lane); expert_convert<false>(we1, we2, gffn, ws, cscr, 16384, 24576, gw4, n4, lane); }
        VM_WAIT(); __syncthreads();
      }
    }
}

__device__ __forceinline__ void router_phase(LAS unsigned char* lds, const bf16_t* __restrict__ H2B, const float* ss2, const bf16_t* wr, const float* brouter, int* topi, float* gatev, int* gcnt, int* rowtok, float* roww, float* rscale, int* slotof, const int G, const int c, const int wid) {
    const int lane = fresh_lane(), tid = wid * 64 + lane, fr = lane & 15, fq = lane >> 4;
    LAS int* hist = (LAS int*)(lds + TAB_OFF) + 576;
    LAS float* lg = (LAS float*)(lds + 131072 + wid * 2112);
    static_assert(131072 + 8 * 2112 <= PHASE_LDS, "router LDS");
    if (tid < 32) hist[tid] = 0;
    { const u32x4* src = (const u32x4*)wr + tid;
#pragma unroll 1
      for (int i0 = 0; i0 < 16; i0 += 8) { u32x4 t[8];
#pragma unroll
          for (int i = 0; i < 8; ++i) t[i] = src[(i0 + i) * 512];
#pragma unroll
          for (int i = 0; i < 8; ++i) *(LAS u32x4*)(lds + ((i0 + i) * 512 + tid) * 16) = t[i]; } }
    __syncthreads();
    for (int task = c * 8 + wid; task < NTOK / 16; task += G * 8) {
        const int tok0 = task * 16;
        f32x4 a0 = (f32x4){0.f, 0.f, 0.f, 0.f}, a1 = a0;
        const bf16_t* ap = H2B + (size_t)(tok0 + fr) * 1024 + fq * 8;
        const LAS unsigned char* bp = lds + lane * 16;
#pragma unroll 1
        for (int k0 = 0; k0 < 32; k0 += 16) { bf16x8 av[16];
#pragma unroll
            for (int i = 0; i < 16; ++i) av[i] = *(const bf16x8*)(ap + (k0 + i) * 32);
#pragma unroll
            for (int i = 0; i < 16; ++i) { const LAS unsigned char* q = bp + (k0 + i) * 4096;
                a0 = __builtin_amdgcn_mfma_f32_16x16x32_bf16(av[i], *(const LAS bf16x8*)(q), a0, 0, 0, 0); a0 = __builtin_amdgcn_mfma_f32_16x16x32_bf16(av[i], *(const LAS bf16x8*)(q + 2048), a0, 0, 0, 0);
                a1 = __builtin_amdgcn_mfma_f32_16x16x32_bf16(av[i], *(const LAS bf16x8*)(q + 1024), a1, 0, 0, 0); a1 = __builtin_amdgcn_mfma_f32_16x16x32_bf16(av[i], *(const LAS bf16x8*)(q + 3072), a1, 0, 0, 0); } }
        const float br0 = brouter[fr], br1 = brouter[16 + fr];
#pragma unroll
        for (int j = 0; j < 4; ++j) { const int t = fq * 4 + j; const float rs = row_rstd16(ss2, tok0 + t); lg[t * 33 + fr] = a0[j] * rs + br0; lg[t * 33 + 16 + fr] = a1[j] * rs + br1; }
        LDS_WAIT();
        if (lane < 16) {
            float v0 = -3e38f, v1 = -3e38f, v2 = -3e38f, v3 = -3e38f; int i0 = 0, i1 = 0, i2 = 0, i3 = 0;
#pragma unroll
            for (int e = 0; e < 32; ++e) { const float v = lg[lane * 33 + e];
                if (v > v0) { v3 = v2; i3 = i2; v2 = v1; i2 = i1; v1 = v0; i1 = i0; v0 = v; i0 = e; }
                else if (v > v1) { v3 = v2; i3 = i2; v2 = v1; i2 = i1; v1 = v; i1 = e; }
                else if (v > v2) { v3 = v2; i3 = i2; v2 = v; i2 = e; }
                else if (v > v3) { v3 = v; i3 = e; } }
            const float e1 = __expf(v1 - v0), e2 = __expf(v2 - v0), e3 = __expf(v3 - v0), inv = 1.0f / (1.0f + e1 + e2 + e3);
            const int tok = tok0 + lane;
            *(int4*)(topi + (size_t)tok * 4) = make_int4(i0, i1, i2, i3);
            *(f32x4*)(gatev + (size_t)tok * 4) = (f32x4){inv, e1 * inv, e2 * inv, e3 * inv};
            atomicAdd((int*)&hist[i0], 1); atomicAdd((int*)&hist[i1], 1); atomicAdd((int*)&hist[i2], 1); atomicAdd((int*)&hist[i3], 1);
        }
        LDS_WAIT();
    }
    __syncthreads();
    LAS int* run = (LAS int*)(lds + TAB_OFF) + 608; LAS int* base = (LAS int*)(lds + TAB_OFF) + 640;
    if (tid < 32) { base[tid] = atomicAdd(&gcnt[tid], hist[tid]); run[tid] = 0; }
    __syncthreads();
    for (int task = c * 8 + wid; task < NTOK / 16; task += G * 8) {
        if (lane < 16) { const int tok = task * 16 + lane; const int4 ti = *(const int4*)(topi + (size_t)tok * 4); const f32x4 gv = *(const f32x4*)(gatev + (size_t)tok * 4);
            const float rs = row_rstd16(ss2, tok); const int ee[4] = {ti.x, ti.y, ti.z, ti.w}; int sl[4];
#pragma unroll
            for (int k = 0; k < 4; ++k) { const int r = base[ee[k]] + atomicAdd((int*)&run[ee[k]], 1); const size_t ix = (size_t)ee[k] * MOE_CAP + r; sl[k] = (ee[k] << 16) | r; rowtok[ix] = tok; roww[ix] = gv[k]; rscale[ix] = rs; }
            *(int4*)(slotof + (size_t)tok * 4) = make_int4(sl[0], sl[1], sl[2], sl[3]); }
    }
}

__device__ __forceinline__ void moe_tables(LAS unsigned char* lds, const int* gcnt, const int G, const int c, const int wid) {
    LAS int* T = (LAS int*)(lds + TAB_OFF); LAS int* blk_e = T; LAS int* tot = T + 672; LAS int* nblkp = T + 704; LAS int* fb = T + 720;
    const int tid = wid * 64 + fresh_lane();
    if (wid == 0) {
        const int l = tid; const int n = (l < 32) ? gcnt[l & 31] : 0; const int nbe = (n + 255) >> 8; int inc = nbe;
#pragma unroll
        for (int o = 1; o < 32; o <<= 1) { const int v = __shfl_up(inc, o); if (l >= o) inc += v; }
        const int pre = inc - nbe;
        if (l < 32) { tot[l] = n; fb[l] = pre; for (int k = 0; k < nbe; ++k) blk_e[pre + k] = l; }
        if (l == 31) nblkp[0] = inc; }
    __syncthreads();
}
__device__ __forceinline__ void moe_pad_rows(LAS unsigned char* lds, int* rowtok, float* roww, float* rscale, const int wid) {
    const LAS int* tot = (const LAS int*)(lds + TAB_OFF) + 672; const int tid = wid * 64 + fresh_lane();
    for (int e = 0; e < 32; ++e) { const int n = tot[e], pe = ((n + 255) >> 8) << 8;
        for (int r = n + tid; r < pe; r += 512) { const size_t ix = (size_t)e * MOE_CAP + r; rowtok[ix] = 0; roww[ix] = 0.f; rscale[ix] = 0.f; } }
    VM_WAIT(); __syncthreads();
}
__device__ __forceinline__ void combine_phase(LAS unsigned char* lds, const bf16_t* __restrict__ H2B, const unsigned char* __restrict__ YS, const int* slotof, const int* gcnt, const float* gfin, float* out, const int G, const int c, const int wid) {
    const int lane = fresh_lane(), tid = wid * 64 + lane;
    moe_tables(lds, gcnt, G, c, wid); const LAS int* fb = (const LAS int*)(lds + TAB_OFF) + 720;
    f32x4 g[4];
#pragma unroll
    for (int q = 0; q < 4; ++q) g[q] = *(const f32x4*)(gfin + q * 256 + lane * 4);
    for (int tok = c * 8 + wid; tok < NTOK; tok += G * 8) {
        const int4 sl = *(const int4*)(slotof + (size_t)tok * 4); const int ss[4] = {fb[sl.x >> 16] * 256 + (sl.x & 0xffff), fb[sl.y >> 16] * 256 + (sl.y & 0xffff), fb[sl.z >> 16] * 256 + (sl.z & 0xffff), fb[sl.w >> 16] * 256 + (sl.w & 0xffff)};
        f32x4 v[4]; float sq = 0.f;
#pragma unroll
        for (int q = 0; q < 4; ++q) { const u32x2 hw = *(const u32x2*)(H2B + (size_t)tok * 1024 + q * 256 + lane * 4); v[q] = (f32x4){bf_lo(hw.x), bf_hi(hw.x), bf_lo(hw.y), bf_hi(hw.y)}; }
#pragma unroll
        for (int k = 0; k < 4; ++k)
#pragma unroll
            for (int q = 0; q < 4; ++q) { const unsigned yw = *(const unsigned*)(YS + (size_t)ss[k] * 1024 + q * 256 + lane * 4);
                const f32x2 y01 = __builtin_amdgcn_cvt_pk_f32_fp8((int)yw, false), y23 = __builtin_amdgcn_cvt_pk_f32_fp8((int)yw, true); v[q] += (f32x4){y01.x, y01.y, y23.x, y23.y}; }
#pragma unroll
        for (int q = 0; q < 4; ++q) sq += (v[q][0] * v[q][0] + v[q][1] * v[q][1]) + (v[q][2] * v[q][2] + v[q][3] * v[q][3]);
        const float rs = __builtin_amdgcn_rsqf(wave_sum(sq) * (1.0f / DM) + EPS);
#pragma unroll
        for (int q = 0; q < 4; ++q) *(f32x4*)(out + (size_t)tok * 1024 + q * 256 + lane * 4) = v[q] * rs * g[q];
    }
}
constexpr int NPHASE = 14;
#ifndef S5P_CONV
#define S5P_CONV(r) true
#define S5P_SCAN(r) true
#endif
__global__ void __launch_bounds__(512, 2) fwd_kernel(Params P) {
    extern __shared__ __attribute__((aligned(16))) unsigned char lds_raw[];
    LAS unsigned char* lds = (LAS unsigned char*)lds_raw;
    const int G = gridDim.x, c = blockIdx.x, wid = __builtin_amdgcn_readfirstlane(threadIdx.x >> 6);
    unsigned char* ws = P.ws;
    volatile LAS unsigned* MISC = (volatile LAS unsigned*)(lds + MISC_OFF);
    if (threadIdx.x < 64) MISC[threadIdx.x] = 0u;
    __syncthreads();
    const int lo = P.ph_lo, hi = P.ph_hi;
    const bool multi = (hi - lo) > 1;
    XcdBarrier bar; bar.bar = (unsigned*)(ws + WS_CTL); bar.x = 0; bar.st = nullptr;
    if (multi) bar = xcd_barrier_post((unsigned*)(ws + WS_CTL), MISC + 8);
#ifndef ONLY_PHASE
#define ONLY_PHASE -1
#endif
#define IN(k) ((ONLY_PHASE < 0 || ONLY_PHASE == (k)) && lo <= (k) && (k) < hi)
#ifndef REP_MASK
#define REP_MASK 0
#endif
#define REPS(k) (((REP_MASK >> (k)) & 1) ? 2 : 1)
#define SEAM(k) do { if (IN(k) && IN((k) + 1)) xcd_barrier(bar, wid); } while (0)
#define SEAM2(k) do { if (IN(k) && IN((k) + 2)) xcd_barrier(bar, wid); } while (0)
    KParams kp0 = (KParams)__builtin_amdgcn_kernarg_segment_ptr(); unsigned char* const ws0 = ws;
#define ENV() KParams pk = kp0; unsigned char* w = ws0; asm volatile("" : "+s"(pk), "+s"(w))
#define BF(off) ((bf16_t*)(w + (off)))
#define F32(off) ((float*)(w + (off)))
#define I32(off) ((int*)(w + (off)))
    constexpr size_t TS1024 = 256 * 1024 * 2, TS512 = 256 * 512 * 2;

    for (int rep_ = 0; rep_ < REPS(0); ++rep_) if (IN(0)) { ENV(); prologue_phase(lds, pk, w, G, c, wid); }
    SEAM(0);
    for (int rep_ = 0; rep_ < REPS(1); ++rep_) if (IN(1)) { ENV();
        P1Sched S{(const char*)(w + WS_XB), (const char*)(w + WS_WIN), (const char*)(w + WS_MEMN), (const char*)(w + WS_WXK), (const char*)(w + WS_WXV), G, c};
        EpiP1 E{w, F32(WS_RSTD0), (const float*)(w + WS_ROPE)};
        pg8::gemm_phase<EpiP1, P1Sched, false, false, false, true>(lds, wid, 1024, 1024, 1024, S, E);
        __syncthreads();
        { P1bSched S8{(const char*)(w + WS_XB8), (const char*)(w + WS_WIN8), G, c};
          pg8::gemm_phase<EpiP1, P1bSched, false, true, false, true>(lds, wid, 512, 512, 512, S8, E); }
    }
    SEAM(1);
    for (int rep_ = 0; rep_ < REPS(2); ++rep_) if (IN(2)) {
        { ENV(); diff_attn_phase<0>(lds, BF(WS_Q), BF(WS_K), BF(WS_VT), BF(WS_OAS), pk->in[I_SUBLN], *(const float*)(w + WS_LAM), G, c, wid); }
#ifdef ATTN_VAR
        { ENV(); diff_attn_phase<ATTN_VAR>(lds, BF(WS_Q), BF(WS_K), BF(WS_VT), (bf16_t*)(w + 900 * MiB), pk->in[I_SUBLN], *(const float*)(w + WS_LAM), G, c, wid); }
#endif
        for (int r2_ = 0; r2_ < REPS(15); ++r2_) { ENV(); s5_phase(lds, BF(WS_U), F32(WS_YP), w + WS_SG, (const float*)(w + WS_S5AB), (const bf16_t*)(w + WS_S5BB), (const bf16_t*)(w + WS_S5CC), pk->in[I_SSMD], pk->in[I_WE1], pk->in[I_WE2], pk->in[I_NFFNG], w, G, c, wid, S5P_CONV(r2_), S5P_SCAN(r2_)); }
    }
    SEAM(2);
    for (int rep_ = 0; rep_ < REPS(3); ++rep_) if (IN(3)) {
        { ENV(); CrossSched S{(const char*)(w + WS_MEMN), (const char*)(w + WS_WXK), (const char*)(w + WS_WXK + MiB), G, c}; EpiP1 E{w, F32(WS_RSTD0), (const float*)(w + WS_ROPE)};
          pg8::gemm_phase<EpiP1, CrossSched, false, true, false, true>(lds, wid, 512, 512, 512, S, E); }
        __syncthreads();
        ENV();
        GluSched S{SimpleSched{(const char*)(w + WS_SG), (const char*)(w + WS_WGLU), TS512 / 2, TS512 / 2, 128, 4, G, c}};
        EpiGlu E{BF(WS_OAS), W8INV / SGSCALE};
        pg8::gemm_phase<EpiGlu, GluSched, false, true>(lds, wid, 256, 256, 256, S, E);
#ifdef GLU_PROBE
        __syncthreads();
        { EpiProbe<GLU_PROBE> E2{(bf16_t*)(w + 900 * MiB)}; pg8::gemm_phase<EpiProbe<GLU_PROBE>, GluSched, false>(lds, wid, 512, 512, 512, S, E2); }
#endif
    }
    SEAM(3);
    for (int rep_ = 0; rep_ < REPS(4); ++rep_) if (IN(4)) { ENV();
        SimpleSched S{(const char*)(w + WS_OAS), (const char*)(w + WS_WBA), TS1024, TS1024, 128, 4, G, c}; EpiGateOut E{BF(WS_GS), BF(WS_MG)}; MidGate MHK{BF(WS_GA), BF(WS_GS)};
        #ifdef NOMID_TEST
        pg8::gemm_phase<EpiGateOut, SimpleSched, false, false, false, true>(lds, wid, 1024, 1024, 1024, S, E);
#else
        pg8::gemm_phase<EpiGateOut, SimpleSched, false, false, false, true, MidGate>(lds, wid, 1024, 1024, 1024, S, E, MHK);
#endif
    }
    SEAM(4);
    for (int rep_ = 0; rep_ < REPS(5); ++rep_) if (IN(5)) { ENV();
        SimpleSched S{(const char*)(w + WS_MG), (const char*)(w + WS_WMIX), TS1024, TS1024, 128, 4, G, c}; EpiResid<false, true> E{(const void*)(w + WS_XB), BF(WS_H1B), F32(WS_SS1), w + WS_H1F8};
        pg8::gemm_phase<EpiResid<false, true>, SimpleSched, false, false, false, true>(lds, wid, 1024, 1024, 1024, S, E);
    }
    SEAM(5);
    for (int rep_ = 0; rep_ < REPS(6); ++rep_) if (IN(6)) {
        { ENV(); SimpleSched S{(const char*)(w + WS_H1F8), (const char*)(w + WS_WXQ8), TS512, TS512, 128, 4, G, c}; EpiXq E{BF(WS_XQ), F32(WS_SS1)};
          pg8::gemm_phase<EpiXq, SimpleSched, false, true, false, true>(lds, wid, 512, 512, 512, S, E); }
#pragma unroll 1
        for (int i = 0; ; ++i) { ENV();
            SimpleSched S{(const char*)(w + WS_H1B), (const char*)(w + WS_WXQ), TS1024, TS1024, 128, 4, G, c}; GUnit uu;
            if (!S.next(i, uu)) break;
            cross_attn_unit(lds, BF(WS_XQ), BF(WS_XK), BF(WS_XVT), w + WS_XO, uu.pm >> 3, uu.pn, uu.pm & 7, wid);
        }
    }
    SEAM(7);
    for (int rep_ = 0; rep_ < REPS(8); ++rep_) if (IN(8)) { ENV();
        SimpleSched S{(const char*)(w + WS_XO), (const char*)(w + WS_WXO), TS512, TS512, 128, 4, G, c}; EpiResid<false> E{(const void*)(w + WS_H1B), BF(WS_H2B), F32(WS_SS2), w + WS_H2F8, W8INV / XOSCALE};
        pg8::gemm_phase<EpiResid<false>, SimpleSched, false, true, false, true>(lds, wid, 512, 512, 512, S, E);
    }
    SEAM(8);
    for (int rep_ = 0; rep_ < REPS(9); ++rep_) if (IN(9)) { ENV(); router_phase(lds, BF(WS_H2B), F32(WS_SS2), (const bf16_t*)(w + WS_WR), pk->in[I_BROUTER], I32(WS_TOPI), F32(WS_GATE), I32(WS_GCNT), I32(WS_ROWTOK), F32(WS_ROWW), F32(WS_RSCALE), I32(WS_SLOT), G, c, wid); }
    SEAM2(9);
    for (int rep_ = 0; rep_ < REPS(11); ++rep_) if (IN(11)) { ENV();
        moe_tables(lds, I32(WS_GCNT), G, c, wid);
        moe_pad_rows(lds, I32(WS_ROWTOK), F32(WS_ROWW), F32(WS_RSCALE), wid);
        const LAS int* T = (const LAS int*)(lds + TAB_OFF);
        MoeSched S{(const char*)(w + WS_H2F8), (const char*)(w + WS_WE1), I32(WS_ROWTOK), T, __builtin_amdgcn_readfirstlane(T[704]), 8, G, c, (size_t)2048 * 1024, true};
        EpiE1 E{w + WS_ACT, F32(WS_RSCALE), pk->in[I_BE1]};
        pg8::gemm_phase<EpiE1, MoeSched, true, true>(lds, wid, 512, 512, 512, S, E);
    }
    SEAM(11);
    for (int rep_ = 0; rep_ < REPS(12); ++rep_) if (IN(12)) { ENV();
        moe_tables(lds, I32(WS_GCNT), G, c, wid);
        const LAS int* T = (const LAS int*)(lds + TAB_OFF);
        MoeSched S{(const char*)(w + WS_ACT), (const char*)(w + WS_WE2), I32(WS_ROWTOK), T, __builtin_amdgcn_readfirstlane(T[704]), 4, G, c, (size_t)1024 * 1024, false};
        EpiE2 E{w + WS_YS, F32(WS_ROWW), pk->in[I_BE2]};
        pg8::gemm_phase<EpiE2, MoeSched, false, true, true, true>(lds, wid, 512, 512, 512, S, E);
#ifdef E2_PROBE
        __syncthreads();
        { EpiProbe<0> E2{(bf16_t*)(w + 900 * MiB)}; pg8::gemm_phase<EpiProbe<0>, MoeSched, false, true, true, true>(lds, wid, 512, 512, 512, S, E2); }
#endif
    }
    SEAM(12);
    for (int rep_ = 0; rep_ < REPS(13); ++rep_) if (IN(13)) { ENV(); combine_phase(lds, BF(WS_H2B), w + WS_YS, I32(WS_SLOT), I32(WS_GCNT), pk->in[I_NFING], pk->out, G, c, wid); }
#undef ENV
#undef BF
#undef F32
#undef I32
#undef IN
#undef SEAM
}

#ifndef N_LAUNCHES
#define N_LAUNCHES 1
#endif
extern "C" void kernel_launch(void* const* d_in, const int* in_sizes, int n_in, void* d_out, int out_size, void* d_ws, size_t ws_size, hipStream_t stream) {
    static int grid = 0;
    if (grid == 0) {
        if (n_in != 34 || out_size != NTOK * DM || ws_size < WS_END) { fprintf(stderr, "kernel_launch: unexpected shapes (n_in %d out %d ws %zu)\n", n_in, out_size, ws_size); grid = -1; return; }
        int dev = 0, cus = 0, per_cu = 0;
        if (hipGetDevice(&dev) != hipSuccess || hipDeviceGetAttribute(&cus, hipDeviceAttributeMultiprocessorCount, dev) != hipSuccess) { grid = -1; return; }
        if (hipFuncSetAttribute((const void*)fwd_kernel, hipFuncAttributeMaxDynamicSharedMemorySize, LDS_BYTES) != hipSuccess) { fprintf(stderr, "kernel_launch: hipFuncSetAttribute failed\n"); grid = -1; return; }
        if (hipOccupancyMaxActiveBlocksPerMultiprocessor(&per_cu, (const void*)fwd_kernel, 512, LDS_BYTES) != hipSuccess || per_cu < 1) { fprintf(stderr, "kernel_launch: occupancy query says %d\n", per_cu); }
        (void)hipGetLastError();
        grid = cus;
    }
    if (grid < 0) return;
    (void)hipMemsetAsync((char*)d_ws + WS_CTL, 0, CTL_ZERO_BYTES, stream);
    Params p{};
    for (int i = 0; i < 34; ++i) p.in[i] = (const float*)d_in[i];
    p.out = (float*)d_out; p.ws = (unsigned char*)d_ws;
#if N_LAUNCHES == 1
    p.ph_lo = 0; p.ph_hi = NPHASE;
    hipLaunchKernelGGL(fwd_kernel, dim3(grid), dim3(512), LDS_BYTES, stream, p);
#else
    for (int k = 0; k < NPHASE; ++k) { p.ph_lo = k; p.ph_hi = k + 1; hipLaunchKernelGGL(fwd_kernel, dim3(grid), dim3(512), LDS_BYTES, stream, p); }
#endif
}
```
